# Optimizing an MI355X kernel written in HIP

```python
import math
import jax, jax.numpy as jnp
from jax import lax
import numpy as np

D_MODEL = 2048
BATCH = 4
SEQ = 8192
DEPTH = 1

D_MIX = D_MODEL
N_ATTN_HEADS = 8
DIFF_HEAD_DIM = 64
ATTN_WIDTH = N_ATTN_HEADS * 2 * DIFF_HEAD_DIM
CONV_WIDTH = D_MIX - ATTN_WIDTH
CONV_TAPS = 3
IN_COLS = 3 * ATTN_WIDTH + 3 * CONV_WIDTH
Q_BLOCK = 128
N_MEM = 256
MEM_HEADS = 4
MEM_HEAD_DIM = D_MODEL // MEM_HEADS
N_EXPERTS = 32
TOP_K = 4
D_FF = D_MODEL
SWIGLU_LIMIT = 7.0
SWIGLU_ALPHA = 1.702
EXPERT_BLOCK = 512
DEEPNORM_ALPHA = (2.0 * DEPTH) ** 0.25
DEEPNORM_BETA = (8.0 * DEPTH) ** -0.25
LN_EPS = 1e-5

kernel_name = "hybrid_diffattn_shortconv_memxattn_moe_deepnorm"


def _layer_norm(x, g, b):
    xf = x.astype(jnp.float32)
    mu = jnp.mean(xf, axis=-1, keepdims=True)
    var = jnp.mean(jnp.square(xf - mu), axis=-1, keepdims=True)
    y = (xf - mu) * lax.rsqrt(var + LN_EPS)
    return (y * g.astype(jnp.float32) + b.astype(jnp.float32)).astype(x.dtype)


def _rms_norm(x, g):
    xf = x.astype(jnp.float32)
    y = xf * lax.rsqrt(jnp.mean(jnp.square(xf), axis=-1, keepdims=True) + LN_EPS)
    return (y * g.astype(jnp.float32)).astype(x.dtype)


def _alibi_slopes(n_heads):
    return jnp.exp2(-8.0 / n_heads * jnp.arange(1, n_heads + 1, dtype=jnp.float32))


def _diff_attention(q, k, v, lam):
    bsz, seq = q.shape[0], q.shape[1]
    nqb = seq // Q_BLOCK
    qb = q.reshape(bsz, nqb, Q_BLOCK, N_ATTN_HEADS, 2, DIFF_HEAD_DIM).transpose(1, 0, 4, 3, 2, 5)
    kt = k.transpose(0, 3, 2, 1, 4)
    vt = v.transpose(0, 2, 1, 3)
    slopes = _alibi_slopes(N_ATTN_HEADS)
    kpos = jnp.arange(seq, dtype=jnp.int32)
    scale = DIFF_HEAD_DIM ** -0.5

    def block(args):
        q_blk, i = args
        qpos = i * Q_BLOCK + jnp.arange(Q_BLOCK, dtype=jnp.int32)
        dist = jnp.abs(qpos[:, None] - kpos[None, :]).astype(jnp.float32)
        bias = -slopes[:, None, None] * dist
        s = jnp.einsum('bmhqd,bmhkd->bmhqk', q_blk, kt).astype(jnp.float32) * scale + bias
        p = jax.nn.softmax(s, axis=-1)
        a = (p[:, 0] - lam * p[:, 1]).astype(vt.dtype)
        return jnp.einsum('bhqk,bhkd->bhqd', a, vt)

    o = lax.map(block, (qb, jnp.arange(nqb, dtype=jnp.int32)))
    return o.transpose(1, 0, 3, 2, 4).reshape(bsz, seq, N_ATTN_HEADS, 2 * DIFF_HEAD_DIM)


def _centred_depthwise_conv3(u, w):
    up = jnp.pad(u, ((0, 0), (1, 1), (0, 0)))
    return up[:, :-2] * w[0] + up[:, 1:-1] * w[1] + up[:, 2:] * w[2]


def _hybrid_mixer(h, w_in, conv_w, subln_w, lq1, lk1, lq2, lk2, w_out, lambda_init):
    bsz, seq, _ = h.shape
    proj = h @ w_in
    a, c = ATTN_WIDTH, CONV_WIDTH
    q, k, v, gate_b, gate_c, u = jnp.split(
        proj, [a, 2 * a, 3 * a, 3 * a + c, 3 * a + 2 * c], axis=-1)
    q = q.reshape(bsz, seq, N_ATTN_HEADS, 2, DIFF_HEAD_DIM)
    k = k.reshape(bsz, seq, N_ATTN_HEADS, 2, DIFF_HEAD_DIM)
    v = v.reshape(bsz, seq, N_ATTN_HEADS, 2 * DIFF_HEAD_DIM)
    lam = (jnp.exp(jnp.sum(lq1.astype(jnp.float32) * lk1.astype(jnp.float32)))
           - jnp.exp(jnp.sum(lq2.astype(jnp.float32) * lk2.astype(jnp.float32)))
           + lambda_init)
    o_attn = _diff_attention(q, k, v, lam)
    o_attn = (_rms_norm(o_attn, subln_w) * (1.0 - lambda_init)).reshape(bsz, seq, ATTN_WIDTH)
    o_conv = gate_b * _centred_depthwise_conv3(gate_c * u, conv_w)
    return jnp.concatenate([o_attn, o_conv], axis=-1) @ w_out


def _memory_attention(h, mem, wq, wkv, wo):
    bsz, seq, _ = h.shape
    n_mem = mem.shape[1]
    q = (h @ wq).reshape(bsz, seq, MEM_HEADS, MEM_HEAD_DIM)
    k, v = jnp.split(mem @ wkv, 2, axis=-1)
    k = k.reshape(bsz, n_mem, MEM_HEADS, MEM_HEAD_DIM)
    v = v.reshape(bsz, n_mem, MEM_HEADS, MEM_HEAD_DIM)
    s = jnp.einsum('bshd,bmhd->bhsm', q, k).astype(jnp.float32) * (MEM_HEAD_DIM ** -0.5)
    p = jax.nn.softmax(s, axis=-1).astype(v.dtype)
    o = jnp.einsum('bhsm,bmhd->bshd', p, v).reshape(bsz, seq, D_MODEL)
    return o @ wo


def _moe(h, router_w, router_b, w_gate, b_gate, w_up, b_up, w_down, b_down):
    bsz, seq, d = h.shape
    n_tok = bsz * seq
    xf = h.reshape(n_tok, d)
    logits = (xf @ router_w + router_b).astype(jnp.float32)
    top_v, top_e = lax.top_k(logits, TOP_K)
    gates = jax.nn.softmax(top_v, axis=-1).astype(h.dtype)
    n_assign = n_tok * TOP_K
    flat_e = top_e.reshape(n_assign).astype(jnp.int32)
    flat_tok = jnp.repeat(jnp.arange(n_tok, dtype=jnp.int32), TOP_K)
    flat_g = gates.reshape(n_assign)
    order = jnp.argsort(flat_e)
    se, stok, sg = flat_e[order], flat_tok[order], flat_g[order]
    counts = jnp.bincount(flat_e, length=N_EXPERTS).astype(jnp.int32)
    starts = jnp.cumsum(counts) - counts
    padded = (counts + EXPERT_BLOCK - 1) // EXPERT_BLOCK * EXPERT_BLOCK
    pad_ends = jnp.cumsum(padded)
    pad_starts = pad_ends - padded
    dest = pad_starts[se] + (jnp.arange(n_assign, dtype=jnp.int32) - starts[se])
    n_blocks = -(-n_assign // EXPERT_BLOCK) + N_EXPERTS
    n_rows = n_blocks * EXPERT_BLOCK
    row_tok = jnp.zeros((n_rows,), jnp.int32).at[dest].set(stok)
    row_g = jnp.zeros((n_rows,), h.dtype).at[dest].set(sg)
    block_start = jnp.arange(n_blocks, dtype=jnp.int32) * EXPERT_BLOCK
    block_e = jnp.minimum(jnp.searchsorted(pad_ends, block_start, side='right'),
                          N_EXPERTS - 1).astype(jnp.int32)

    def expert_block(args):
        e, tok, g = args
        xb = xf[tok]
        gate = xb @ w_gate[e] + b_gate[e]
        up = xb @ w_up[e] + b_up[e]
        gate = jnp.minimum(gate, SWIGLU_LIMIT)
        up = jnp.clip(up, -SWIGLU_LIMIT, SWIGLU_LIMIT)
        act = gate * jax.nn.sigmoid(SWIGLU_ALPHA * gate) * (up + 1.0)
        return (act @ w_down[e] + b_down[e]) * g[:, None]

    outs = lax.map(expert_block, (block_e,
                                  row_tok.reshape(n_blocks, EXPERT_BLOCK),
                                  row_g.reshape(n_blocks, EXPERT_BLOCK)))
    y = jnp.zeros((n_tok, d), h.dtype).at[row_tok].add(outs.reshape(n_rows, d))
    return y.reshape(bsz, seq, d)


def _nrm(k, shape, scale):
    return scale * jax.random.normal(k, shape, jnp.float32)


def setup_inputs(seed: int = 0) -> dict:
    key = jax.random.key(seed)
    ks = jax.random.split(key, 32)
    L, D, E, F = DEPTH, D_MODEL, N_EXPERTS, D_FF
    beta = DEEPNORM_BETA
    col_scale = jnp.concatenate([
        jnp.ones((2 * ATTN_WIDTH,), jnp.float32),
        jnp.full((ATTN_WIDTH,), beta, jnp.float32),
        jnp.ones((3 * CONV_WIDTH,), jnp.float32)])
    kv_scale = jnp.concatenate([jnp.ones((D,), jnp.float32), jnp.full((D,), beta, jnp.float32)])
    return {
        "x": _nrm(ks[0], (BATCH, SEQ, D), 1.0),
        "mem": _nrm(ks[1], (BATCH, N_MEM, D), 1.0),
        "w_in": _nrm(ks[2], (L, D, IN_COLS), D ** -0.5) * col_scale,
        "conv_w": _nrm(ks[3], (L, CONV_TAPS, CONV_WIDTH), 0.5),
        "attn_subln_w": 1.0 + _nrm(ks[4], (L, 2 * DIFF_HEAD_DIM), 0.02),
        "lambda_q1": _nrm(ks[5], (L, DIFF_HEAD_DIM), 0.1),
        "lambda_k1": _nrm(ks[6], (L, DIFF_HEAD_DIM), 0.1),
        "lambda_q2": _nrm(ks[7], (L, DIFF_HEAD_DIM), 0.1),
        "lambda_k2": _nrm(ks[8], (L, DIFF_HEAD_DIM), 0.1),
        "w_out": _nrm(ks[9], (L, D_MIX, D), D_MIX ** -0.5 * beta),
        "ln1_g": 1.0 + _nrm(ks[10], (L, D), 0.02),
        "ln1_b": _nrm(ks[11], (L, D), 0.02),
        "mem_wq": _nrm(ks[12], (L, D, D), D ** -0.5),
        "mem_wkv": _nrm(ks[13], (L, D, 2 * D), D ** -0.5) * kv_scale,
        "mem_wo": _nrm(ks[14], (L, D, D), D ** -0.5 * beta),
        "ln2_g": 1.0 + _nrm(ks[15], (L, D), 0.02),
        "ln2_b": _nrm(ks[16], (L, D), 0.02),
        "router_w": _nrm(ks[17], (L, D, E), D ** -0.5),
        "router_b": _nrm(ks[18], (L, E), 0.01),
        "w_gate": _nrm(ks[19], (L, E, D, F), D ** -0.5),
        "b_gate": _nrm(ks[20], (L, E, F), 0.01),
        "w_up": _nrm(ks[21], (L, E, D, F), D ** -0.5),
        "b_up": _nrm(ks[22], (L, E, F), 0.01),
        "w_down": _nrm(ks[23], (L, E, F, D), F ** -0.5 * beta),
        "b_down": _nrm(ks[24], (L, E, D), 0.01),
        "ln3_g": 1.0 + _nrm(ks[25], (L, D), 0.02),
        "ln3_b": _nrm(ks[26], (L, D), 0.02),
    }


def reference(x, mem, w_in, conv_w, attn_subln_w, lambda_q1, lambda_k1, lambda_q2, lambda_k2,
              w_out, ln1_g, ln1_b, mem_wq, mem_wkv, mem_wo, ln2_g, ln2_b,
              router_w, router_b, w_gate, b_gate, w_up, b_up, w_down, b_down,
              ln3_g, ln3_b):
    for l in range(DEPTH):
        lambda_init = 0.8 - 0.6 * math.exp(-0.3 * l)
        mix = _hybrid_mixer(x, w_in[l], conv_w[l], attn_subln_w[l], lambda_q1[l], lambda_k1[l],
                            lambda_q2[l], lambda_k2[l], w_out[l], lambda_init)
        x = _layer_norm(DEEPNORM_ALPHA * x + mix, ln1_g[l], ln1_b[l])
        xa = _memory_attention(x, mem, mem_wq[l], mem_wkv[l], mem_wo[l])
        x = _layer_norm(DEEPNORM_ALPHA * x + xa, ln2_g[l], ln2_b[l])
        ff = _moe(x, router_w[l], router_b[l], w_gate[l], b_gate[l], w_up[l], b_up[l],
                  w_down[l], b_down[l])
        x = _layer_norm(DEEPNORM_ALPHA * x + ff, ln3_g[l], ln3_b[l])
    return x
```

```cpp
#include <hip/hip_runtime.h>
#include <cstdio>
#include <cstdint>

#ifndef PROBE_MASK
#define PROBE_MASK 0
#endif
#ifndef MK_ONE_LAUNCH
#define MK_ONE_LAUNCH 1
#endif

#define GAS __attribute__((address_space(1)))
#define LAS __attribute__((address_space(3)))
typedef unsigned short bf16_t;
typedef short bf16x8 __attribute__((ext_vector_type(8)));
typedef float f32x4 __attribute__((ext_vector_type(4)));
typedef float f32x16 __attribute__((ext_vector_type(16)));
typedef unsigned u32x4 __attribute__((ext_vector_type(4)));
typedef unsigned u32x2 __attribute__((ext_vector_type(2)));
typedef GAS unsigned gu32;
typedef int v4i32 __attribute__((ext_vector_type(4)));
typedef int v8i32 __attribute__((ext_vector_type(8)));

constexpr int BATCH = 4, SEQ = 8192, DM = 2048, NTOK = BATCH * SEQ;
constexpr int NH = 8, HD = 64, AW = 1024, CW = 1024, PROJ_N = 5120;
constexpr int NMEM = 256, MH = 4, MHD = 512;
constexpr int NE = 32, TOPK = 4, FF = 2048;
constexpr float ALPHA = 1.189207115002721f;
constexpr float LN_EPS = 1e-5f;
constexpr float LOG2E = 1.4426950408889634f;
constexpr float QSCALE = 0.125f * LOG2E;
constexpr float MQSCALE = 0.044194173824159216f * LOG2E;
constexpr float LAMBDA_INIT = 0.2f;
constexpr float SW_LIMIT = 7.0f, SW_ALPHA = 1.702f;
constexpr float ATT_THR = 40.0f;

constexpr size_t MiB = 1u << 20;
constexpr size_t WS_CTL = 0, CTL_ZERO_BYTES = 1 * MiB;
constexpr size_t WS_ELTOK = 1 * MiB;
constexpr size_t WS_ELGATE = 5 * MiB;
constexpr size_t WS_TOKSLOT = 9 * MiB;
constexpr size_t WS_ROUTT = 10 * MiB;
constexpr size_t WS_STAT1 = 10 * MiB + 256 * 1024;
constexpr size_t WS_STAT2 = 10 * MiB + 512 * 1024;
constexpr size_t WS_WINA = 11 * MiB;
constexpr size_t WS_WINV = 31 * MiB;
constexpr size_t WS_WOUT = 35 * MiB;
constexpr size_t WS_WQ = 43 * MiB;
constexpr size_t WS_WKV = 51 * MiB;
constexpr size_t WS_WO = 67 * MiB;
constexpr size_t WS_MEMB = 75 * MiB;
constexpr size_t WS_KMEM = 79 * MiB;
constexpr size_t WS_VMEMT = 83 * MiB;
constexpr size_t WS_WGU = 88 * MiB;
constexpr size_t WS_WD = 344 * MiB;
constexpr size_t WS_R1 = 472 * MiB;
constexpr size_t WS_R2 = 600 * MiB;
constexpr size_t WS_PROJ = WS_R2;
constexpr size_t WS_VT = WS_R2 + 320 * MiB;
constexpr size_t WS_MIX = WS_R2 + 384 * MiB;
constexpr size_t WS_MT = WS_R2;
constexpr size_t WS_VWT = WS_R2 + 8 * MiB;
constexpr size_t WS_P = WS_R2 + 128 * MiB;
constexpr size_t WS_H = WS_R2;
constexpr size_t WS_Y = 1113 * MiB;
constexpr size_t WS_Z = 1625 * MiB;
constexpr size_t WS_END = 1753 * MiB;
constexpr float WG_SCALE = 32.0f, WD_SCALE = 64.0f, WQ8_SCALE = 32.0f, Y_SCALE = 16.0f, WO8_SCALE = 64.0f, M8_DIV = 16.0f, VW8_DIV = 8.0f, P8_SCALE = 256.0f;

constexpr int CW_BAR = 4096;
constexpr int CW_ECNT = 16384;
constexpr int CW_KNMAX = 16512;
constexpr int CW_ATTQ = 16640;
constexpr int CW_RC = 17000;

constexpr int RING_BYTES = 131072;
constexpr int XTRA_OFF = RING_BYTES;
constexpr int MISC_OFF = RING_BYTES + 15360;
constexpr int LDS_BYTES = 147456;
constexpr int NWAVES = 8;

__device__ __forceinline__ unsigned f2bf(float f) { unsigned u = __builtin_bit_cast(unsigned, f); return (u + 0x7fffu + ((u >> 16) & 1u)) >> 16; }
__device__ __forceinline__ unsigned pk2_sw(float lo, float hi) { return f2bf(lo) | (f2bf(hi) << 16); }
__device__ __forceinline__ unsigned cvt_pk_bf16_asm(float lo, float hi) { unsigned r; asm volatile("v_cvt_pk_bf16_f32 %0, %1, %2" : "=v"(r) : "v"(lo), "v"(hi)); return r; }
typedef float f32x2c_t __attribute__((ext_vector_type(2))); typedef __bf16 bf16x2c_t __attribute__((ext_vector_type(2)));
__device__ __forceinline__ unsigned cvt_pk_bf16_c(float lo, float hi) { f32x2c_t v = {lo, hi}; bf16x2c_t b = __builtin_convertvector(v, bf16x2c_t); return __builtin_bit_cast(unsigned, b); }
__device__ __forceinline__ float bflo(unsigned w) { return __uint_as_float(w << 16); }
__device__ __forceinline__ float bfhi(unsigned w) { return __uint_as_float(w & 0xffff0000u); }
__device__ __forceinline__ int opaque(int x) { asm volatile("" : "+v"(x)); return x; }
#define RLX_AGENT __ATOMIC_RELAXED, __HIP_MEMORY_SCOPE_AGENT
#define LDS_WAIT() asm volatile("s_waitcnt lgkmcnt(0)" ::: "memory")
__device__ __forceinline__ float wave_sum(float v) {
#pragma unroll
    for (int o = 1; o < 64; o <<= 1) v += __shfl_xor(v, o);
    return v;
}
__device__ __forceinline__ float wave_max(float v) {
#pragma unroll
    for (int o = 1; o < 64; o <<= 1) v = fmaxf(v, __shfl_xor(v, o));
    return v;
}

__device__ __forceinline__ void glds16v(const void* vptr, unsigned lds_dst) { unsigned keep;
    asm volatile("s_mov_b32 %0, m0\n\ts_mov_b32 m0, %2\n\ts_nop 0\n\tglobal_load_lds_dwordx4 %1, off\n\ts_mov_b32 m0, %0" : "=&s"(keep) : "v"(vptr), "s"(lds_dst) : "memory"); }

#define XB_TMO      128
#define XB_XCNT(j)  (256  + 64 * (j))
#define XB_XSUB(j)  (1280 + 64 * (j))
#define XB_XGEN(j)  (2304 + 64 * (j))
#define XB_TOP      3328
#define XB_TOPGEN   3392
#define XCD_BAR_WORDS 3456
#define XB_SPIN_CAP (1u << 18)
__device__ __forceinline__ unsigned xb_ld(unsigned* p)              { return __hip_atomic_load(p, __ATOMIC_RELAXED, __HIP_MEMORY_SCOPE_AGENT); }
__device__ __forceinline__ unsigned xb_add(unsigned* p, unsigned v) { return __hip_atomic_fetch_add(p, v, __ATOMIC_RELAXED, __HIP_MEMORY_SCOPE_AGENT); }
__device__ __forceinline__ unsigned xb_xcc_id() { return (unsigned)__builtin_amdgcn_s_getreg((3 << 11) | 20) & 0xFu; }
#define XB_SPIN(cond, bar) do { unsigned _sp = 0; while (cond) { __builtin_amdgcn_s_sleep(1); \
    if ((++_sp & 255u) == 0u) { if (xb_ld(&(bar)[XB_TMO])) break; if (_sp > XB_SPIN_CAP) { atomicAdd(&(bar)[XB_TMO], 1u); break; } } } } while (0)
struct XcdBarrier { unsigned* bar; unsigned x; volatile LAS unsigned* st; };
__device__ __forceinline__ XcdBarrier xcd_barrier_post(unsigned* bar, volatile LAS unsigned* st) {
    XcdBarrier b; b.bar = bar; b.x = xb_xcc_id(); b.st = st;
    if (threadIdx.x == 0) (void)xb_add(&bar[XB_XCNT(b.x)], 1u);
    return b;
}
__device__ __forceinline__ void xcd_barrier_complete(unsigned* bar, unsigned x, unsigned& nloc, unsigned& nx) {
    const unsigned G = gridDim.x * gridDim.y * gridDim.z;
    unsigned sum, cnt, mine, sp = 0u;
    for (;;) {
        sum = 0u; cnt = 0u; mine = 0u;
#pragma unroll
        for (unsigned j = 0; j < 16; ++j) { const unsigned c = xb_ld(&bar[XB_XCNT(j)]); sum += c; cnt += (c > 0u) ? 1u : 0u; mine = (j == x) ? c : mine; }
        if (sum == G) break;
        __builtin_amdgcn_s_sleep(1);
        if ((++sp & 255u) == 0u) { if (xb_ld(&bar[XB_TMO])) break; if (sp > XB_SPIN_CAP) { atomicAdd(&bar[XB_TMO], 1u); break; } }
    }
    nloc = mine > 0u ? mine : 1u; nx = cnt > 0u ? cnt : 1u;
}
__device__ __forceinline__ void xcd_barrier(const XcdBarrier& b) {
    asm volatile("s_waitcnt vmcnt(0)" ::: "memory");
    __syncthreads();
    if (threadIdx.x == 0) {
        unsigned* bar = b.bar;
        __builtin_amdgcn_s_waitcnt(0);
        unsigned nloc = b.st[0], nx = b.st[1];
        if (nloc == 0u) { xcd_barrier_complete(bar, b.x, nloc, nx); b.st[0] = nloc; b.st[1] = nx; }
        const unsigned old = xb_add(&bar[XB_XSUB(b.x)], 1u);
        const unsigned gen = old / nloc;
        if (old + 1u == (gen + 1u) * nloc) {
            __builtin_amdgcn_fence(__ATOMIC_RELEASE, "agent");
            asm volatile("s_waitcnt vmcnt(0)" ::: "memory");
            const unsigned og = xb_add(&bar[XB_TOP], 1u);
            const unsigned tg = og / nx;
            if (og + 1u == (tg + 1u) * nx) xb_add(&bar[XB_TOPGEN], 1u);
            else XB_SPIN(xb_ld(&bar[XB_TOPGEN]) == tg, bar);
            __builtin_amdgcn_fence(__ATOMIC_ACQUIRE, "agent");
            xb_add(&bar[XB_XGEN(b.x)], 1u);
            asm volatile("s_waitcnt vmcnt(0)" ::: "memory");
        } else {
            XB_SPIN(xb_ld(&bar[XB_XGEN(b.x)]) == gen, bar);
            __builtin_amdgcn_fence(__ATOMIC_ACQUIRE, "agent");
            asm volatile("s_waitcnt vmcnt(0)" ::: "memory");
        }
    }
    __syncthreads();
}

namespace pg8 {
constexpr int BM = 256, BK = 64, HALF = 128, HTB = HALF * BK * 2, STAGE_BYTES = 8 * HTB, NXCD = 8;
__host__ __device__ __forceinline__ int lds_byte(int r, int c) { const int st = (r >> 4) * 2 + (c >> 5), rr = r & 15, cc = c & 31, ob = rr * 64 + cc * 2; return st * 1024 + (ob ^ (((ob >> 9) & 1) << 5)); }
__host__ __device__ __forceinline__ void stage_rc(int b, int& R, int& C) { const int st = b / 1024, sb = b % 1024, swz = sb ^ (((sb >> 9) & 1) << 5); R = (st >> 1) * 16 + swz / 64; C = (st & 1) * 32 + (swz % 64) / 2; }
__host__ __device__ __forceinline__ int perm32(int rho) { const int n = rho >> 4, i = rho & 15; return 8 * (i >> 2) + 4 * n + (i & 3); }

struct Unit { int pm, pn, g, rs, cnt; };

__device__ __forceinline__ int xcd_chunk(int L, int nwg) { const int q = nwg / NXCD, r = nwg % NXCD, xcd = L % NXCD, off = L / NXCD; return (xcd < r ? xcd * (q + 1) : r * (q + 1) + (xcd - r) * q) + off; }
__device__ __forceinline__ void tile_of(int w, int nM, int nN, int WGM, int& pm, int& pn) { const int nig = WGM * nN, gid = w / nig, fm = gid * WGM, gsz = (nM - fm) < WGM ? (nM - fm) : WGM; pm = fm + ((w % nig) % gsz); pn = (w % nig) / gsz; }

typedef f32x4 Acc[2][2][4][2];

__device__ __forceinline__ void store_tile_bf16(const Acc& acc, bf16_t* O, size_t ldc, int wr, int wc, int fr_, int fq) {
    const int fr = opaque(fr_);
#pragma unroll
    for (int ai = 0; ai < 2; ++ai)
#pragma unroll
        for (int m = 0; m < 4; ++m) { bf16_t* rowp = O + (size_t)(ai * HALF + wr * 64 + m * 16 + fr) * ldc + wc * 32 + 8 * fq;
#pragma unroll
            for (int bj = 0; bj < 2; ++bj) { const f32x4 v0 = acc[ai][bj][m][0], v1 = acc[ai][bj][m][1];
                u32x4 w; w.x = cvt_pk_bf16_c(v0[0], v0[1]); w.y = cvt_pk_bf16_c(v0[2], v0[3]); w.z = cvt_pk_bf16_c(v1[0], v1[1]); w.w = cvt_pk_bf16_c(v1[2], v1[3]);
                *(u32x4*)(rowp + bj * HALF) = w; } }
}

__device__ __forceinline__ u32x4 pair16(u32x2 a, u32x2 b) {
    const auto sx = __builtin_amdgcn_permlane16_swap(a.x, b.x, false, false), sy = __builtin_amdgcn_permlane16_swap(a.y, b.y, false, false);
    u32x4 q; q.x = sx[0]; q.y = sy[0]; q.z = sx[1]; q.w = sy[1]; return q; }
__device__ __forceinline__ u32x2 pack8_fp8(f32x4 v0, f32x4 v1) {
    int p0 = __builtin_amdgcn_cvt_pk_fp8_f32(v0[0], v0[1], 0, false); p0 = __builtin_amdgcn_cvt_pk_fp8_f32(v0[2], v0[3], p0, true);
    int p1 = __builtin_amdgcn_cvt_pk_fp8_f32(v1[0], v1[1], 0, false); p1 = __builtin_amdgcn_cvt_pk_fp8_f32(v1[2], v1[3], p1, true);
    u32x2 w; w.x = (unsigned)p0; w.y = (unsigned)p1; return w; }
__device__ __forceinline__ void store_tile_fp8(const Acc& acc, unsigned char* O, size_t ldc, float scale, int wr, int wc, int fr_, int fq) {
    const int fr = opaque(fr_);
    const int coff = wc * 32 + ((fq & 1) ? HALF + 8 * (fq - 1) : 8 * fq);
#pragma unroll
    for (int ai = 0; ai < 2; ++ai)
#pragma unroll
        for (int m = 0; m < 4; ++m) { unsigned char* rowp = O + (size_t)(ai * HALF + wr * 64 + m * 16 + fr) * ldc + coff;
            const u32x2 w0 = pack8_fp8(acc[ai][0][m][0] * scale, acc[ai][0][m][1] * scale), w1 = pack8_fp8(acc[ai][1][m][0] * scale, acc[ai][1][m][1] * scale);
            *(u32x4*)rowp = pair16(w0, w1); }
}

template <class Prob> struct a_blocked { static constexpr bool value = false; };
template <class Epi, class Prob, bool ALIGN_EPI>
__device__ __forceinline__ void gemm_phase(LAS unsigned char* lds, const Prob& P, const Epi& E) {
    const int tid = threadIdx.x, wid = __builtin_amdgcn_readfirstlane(tid >> 6), lane = tid & 63, wr = wid >> 2, wc = wid & 3, fr = lane & 15, fq = lane >> 4;
    const int nt = P.Kb / 128;
    int Rl[2], Cl[2]; unsigned voffA[2][2], voffAn[2][2], voffB[2];
#pragma unroll
    for (int i = 0; i < 2; ++i) { int R, C; stage_rc(tid * 16 + i * 8192, R, C); Rl[i] = R; Cl[i] = C; const int Rb = Epi::PERM ? ((R & ~31) + perm32(R & 31)) : R;
        voffB[i] = (unsigned)(Rb * P.ldb + C * 2);
        if constexpr (a_blocked<Prob>::value) { const int cb = C * 2;
            voffA[0][i] = (unsigned)((R & ~31) * 2048 + (R & 31) * 32 + (cb >> 5) * 1024 + (cb & 31)); voffA[1][i] = voffA[0][i] + (unsigned)(HALF * 2048); }
        else { voffA[0][i] = (unsigned)(R * P.lda + C * 2); voffA[1][i] = (unsigned)((R + HALF) * P.lda + C * 2); }
        voffAn[0][i] = voffA[0][i]; voffAn[1][i] = voffA[1][i]; }
    const size_t kstep = (size_t)(BK * 2), kstepA = a_blocked<Prob>::value ? (size_t)4096 : kstep;
    const size_t hstepB = (size_t)HALF * P.ldb;
    const unsigned ldsw = (unsigned)wid * 1024u;
    const int aoff = lds_byte(wr * 64 + fr, fq * 8), boff = lds_byte(wc * 32 + fr, fq * 8);
#define PG8_SA(b, h) (((b) * 2 + (h)) * HTB)
#define PG8_SB(b, h) ((4 + (b) * 2 + (h)) * HTB)
#define PG8_STAGE(bufoff, gbase, voff) do { _Pragma("unroll") for (int _i = 0; _i < 2; ++_i) \
        __builtin_amdgcn_global_load_lds((const unsigned*)((const char*)(gbase) + (voff)[_i]), (LAS unsigned*)(lds + (bufoff) + ldsw + _i * 8192), 16, 0, 0); } while (0)
#define PG8_LD8(base_) __builtin_shufflevector(*(const LAS v4i32*)(base_), *(const LAS v4i32*)((base_) + 1024), 0, 1, 2, 3, 4, 5, 6, 7)
#define PG8_LDA(dst, b, h) do { _Pragma("unroll") for (int m = 0; m < 4; ++m) dst[m] = PG8_LD8(lds + PG8_SA(b, h) + aoff + m * 2048); } while (0)
#define PG8_LDB(dst, b, h) do { _Pragma("unroll") for (int n = 0; n < 2; ++n) dst[n] = PG8_LD8(lds + PG8_SB(b, h) + boff + n * 2048); } while (0)
#define PG8_LO(v) __builtin_bit_cast(bf16x8, __builtin_shufflevector(v, v, 0, 1, 2, 3))
#define PG8_HI(v) __builtin_bit_cast(bf16x8, __builtin_shufflevector(v, v, 4, 5, 6, 7))
#define PG8_MMA(ai, bj, At, Bt) do { __builtin_amdgcn_s_setprio(1); _Pragma("unroll") for (int m = 0; m < 4; ++m) _Pragma("unroll") for (int n = 0; n < 2; ++n) { \
        if constexpr (Prob::FP8) { asm volatile("v_mfma_f32_16x16x128_f8f6f4 %0, %1, %2, %0" : "+v"(acc[ai][bj][m][n]) : "v"(Bt[n]), "v"(At[m])); } \
        else { acc[ai][bj][m][n] = __builtin_amdgcn_mfma_f32_16x16x32_bf16(PG8_LO(Bt[n]), PG8_LO(At[m]), acc[ai][bj][m][n], 0, 0, 0); \
               acc[ai][bj][m][n] = __builtin_amdgcn_mfma_f32_16x16x32_bf16(PG8_HI(Bt[n]), PG8_HI(At[m]), acc[ai][bj][m][n], 0, 0, 0); } } __builtin_amdgcn_s_setprio(0); } while (0)
#define PG8_MMAZ(ai, bj, At, Bt) do { __builtin_amdgcn_s_setprio(1); _Pragma("unroll") for (int m = 0; m < 4; ++m) _Pragma("unroll") for (int n = 0; n < 2; ++n) { \
        asm volatile("v_mfma_f32_16x16x128_f8f6f4 %0, %1, %2, 0" : "+v"(acc[ai][bj][m][n]) : "v"(Bt[n]), "v"(At[m])); } __builtin_amdgcn_s_setprio(0); } while (0)
#define PG8_WAIT_V(n) asm volatile("s_waitcnt vmcnt(" #n ")" ::: "memory")
#define PG8_WAIT_L(n) asm volatile("s_waitcnt lgkmcnt(" #n ")" ::: "memory")
#define PG8_BAR __builtin_amdgcn_s_barrier()
#define PG8_SCHED __builtin_amdgcn_sched_barrier(0)
    Unit cur, nxt; int ui = 0;
    if (!P.next(0, cur)) return;
    Acc acc;
#pragma unroll
    for (int a = 0; a < 2; ++a)
#pragma unroll
        for (int b = 0; b < 2; ++b)
#pragma unroll
            for (int m = 0; m < 4; ++m)
#pragma unroll
                for (int n = 0; n < 2; ++n) acc[a][b][m][n] = (f32x4){0.f, 0.f, 0.f, 0.f};
    v8i32 At[4], B0[2], B1[2];
    const char* cA = P.a_base(cur); const char* cB = P.b_base(cur);
    int mslot = 0;
    if constexpr (Prob::META) { P.meta_prefetch(cur, 0, wid, lane); asm volatile("s_waitcnt vmcnt(0)" ::: "memory"); __builtin_amdgcn_s_barrier(); asm volatile("" ::: "memory"); }
    if constexpr (Prob::GATHER) P.a_rows(cur, 0, Rl, Cl, voffA);
    PG8_STAGE(PG8_SB(0, 0), cB, voffB); PG8_STAGE(PG8_SB(0, 1), cB + hstepB, voffB); PG8_STAGE(PG8_SA(0, 0), cA, voffA[0]); PG8_STAGE(PG8_SA(0, 1), cA, voffA[1]);
    if (wr == 1) PG8_BAR;
    PG8_WAIT_V(2); PG8_BAR;
    PG8_STAGE(PG8_SB(1, 0), cB + kstep, voffB); PG8_STAGE(PG8_SA(1, 0), cA + kstepA, voffA[0]); PG8_STAGE(PG8_SB(1, 1), cB + hstepB + kstep, voffB);
    PG8_WAIT_V(6); PG8_BAR;
    for (;;) {
        bool lower_only = false;
        if constexpr (Prob::META) lower_only = P.lower_only(cur);
        const bool has_next = P.next(ui + 1, nxt);
        const char* nA = has_next ? P.a_base(nxt) : cA; const char* nB = has_next ? P.b_base(nxt) : cB;
        const int nslot = (mslot == 2) ? 0 : mslot + 1;
        if constexpr (Prob::META) { if (has_next) P.meta_prefetch(nxt, nslot, wid, lane); }
        for (int t = 0; t < nt; t += 2) {
            const bool last = (t == nt - 2);
            const char* a1 = cA + (size_t)(t + 1) * kstepA;
            const char* a2 = last ? nA : cA + (size_t)(t + 2) * kstepA; const char* b2 = last ? nB : cB + (size_t)(t + 2) * kstep;
            const char* a3 = a2 + kstepA; const char* b3 = b2 + kstep;
            unsigned sA[2][2];
#pragma unroll
            for (int h = 0; h < 2; ++h)
#pragma unroll
                for (int i = 0; i < 2; ++i) sA[h][i] = voffA[h][i];
            if constexpr (Prob::GATHER) { if (last && has_next) { P.a_rows(nxt, nslot, Rl, Cl, voffAn);
#pragma unroll
                for (int h = 0; h < 2; ++h)
#pragma unroll
                    for (int i = 0; i < 2; ++i) sA[h][i] = voffAn[h][i]; } }
            PG8_LDB(B0, 0, 0); PG8_LDB(B1, 0, 1); PG8_SCHED; PG8_LDA(At, 0, 0); PG8_STAGE(PG8_SA(1, 1), a1, voffA[1]);
            PG8_WAIT_V(8); PG8_WAIT_L(0); PG8_BAR; if (Prob::FP8 && t == 0) { PG8_MMAZ(0, 0, At, B0); PG8_MMAZ(0, 1, At, B1); } else { PG8_MMA(0, 0, At, B0); PG8_MMA(0, 1, At, B1); } PG8_BAR; PG8_SCHED;
            PG8_LDA(At, 0, 1); PG8_STAGE(PG8_SB(0, 0), b2, voffB); PG8_STAGE(PG8_SB(0, 1), b2 + hstepB, voffB); PG8_STAGE(PG8_SA(0, 0), a2, sA[0]);
            PG8_WAIT_V(8); PG8_WAIT_L(0); PG8_BAR; if (!lower_only) { if (Prob::FP8 && t == 0) { PG8_MMAZ(1, 0, At, B0); PG8_MMAZ(1, 1, At, B1); } else { PG8_MMA(1, 0, At, B0); PG8_MMA(1, 1, At, B1); } } PG8_BAR; PG8_SCHED;
            PG8_LDB(B0, 1, 0); PG8_LDB(B1, 1, 1); PG8_SCHED; PG8_LDA(At, 1, 0); PG8_STAGE(PG8_SA(0, 1), a2, sA[1]);
            PG8_WAIT_V(8); PG8_WAIT_L(0); PG8_BAR; PG8_MMA(0, 0, At, B0); PG8_MMA(0, 1, At, B1); PG8_BAR; PG8_SCHED;
            PG8_LDA(At, 1, 1); PG8_STAGE(PG8_SB(1, 0), b3, voffB); PG8_STAGE(PG8_SB(1, 1), b3 + hstepB, voffB); PG8_STAGE(PG8_SA(1, 0), a3, sA[0]);
            PG8_WAIT_V(8); PG8_WAIT_L(0); PG8_BAR; if (!lower_only) { PG8_MMA(1, 0, At, B0); PG8_MMA(1, 1, At, B1); } PG8_BAR; PG8_SCHED;
        }
        if constexpr (ALIGN_EPI) { if (wr == 0) PG8_BAR; }
        if constexpr (Prob::FP8) {
#pragma unroll
            for (int a = 0; a < 2; ++a)
#pragma unroll
                for (int b = 0; b < 2; ++b) asm volatile("s_nop 15\n\ts_nop 3" : "+v"(acc[a][b][0][0]), "+v"(acc[a][b][0][1]), "+v"(acc[a][b][1][0]), "+v"(acc[a][b][1][1]), "+v"(acc[a][b][2][0]), "+v"(acc[a][b][2][1]), "+v"(acc[a][b][3][0]), "+v"(acc[a][b][3][1])); }
        if constexpr (Prob::META) E(acc, cur, wr, wc, fr, fq, mslot); else E(acc, cur, wr, wc, fr, fq);
        if (!has_next) break;
        if constexpr (!Prob::FP8) {
#pragma unroll
        for (int a = 0; a < 2; ++a)
#pragma unroll
            for (int b = 0; b < 2; ++b)
#pragma unroll
                for (int m = 0; m < 4; ++m)
#pragma unroll
                    for (int n = 0; n < 2; ++n) acc[a][b][m][n] = (f32x4){0.f, 0.f, 0.f, 0.f}; }
        cur = nxt; cA = nA; cB = nB; ++ui; mslot = nslot;
        if constexpr (Prob::GATHER) {
#pragma unroll
            for (int h = 0; h < 2; ++h)
#pragma unroll
                for (int i = 0; i < 2; ++i) voffA[h][i] = voffAn[h][i]; }
        if constexpr (ALIGN_EPI) { if (wr == 1) PG8_BAR; }
    }
    PG8_WAIT_V(0);
    if constexpr (!ALIGN_EPI) { if (wr == 0) PG8_BAR; }
    PG8_BAR;
#undef PG8_SA
#undef PG8_SB
#undef PG8_STAGE
#undef PG8_LDA
#undef PG8_LD8
#undef PG8_LO
#undef PG8_HI
#undef PG8_LDB
#undef PG8_MMA
#undef PG8_MMAZ
#undef PG8_WAIT_V
#undef PG8_WAIT_L
#undef PG8_BAR
#undef PG8_SCHED
}
}

struct Frame {
    LAS unsigned char* lds;
    gu32* ctl;
    unsigned char* ws;
    int tid, lane, wave, vcu, G;
    const float* in[27];
    float* out;
};
enum { I_X = 0, I_MEM, I_WIN, I_CONVW, I_SUBLN, I_LQ1, I_LK1, I_LQ2, I_LK2, I_WOUT, I_LN1G, I_LN1B, I_MWQ, I_MWKV, I_MWO, I_LN2G, I_LN2B,
       I_RW, I_RB, I_WG, I_BG, I_WU, I_BU, I_WD, I_BD, I_LN3G, I_LN3B };

struct P0Item { const float* W; unsigned char* WT; int row_off; float scale; int k0, n0; };
__device__ __forceinline__ P0Item p0_expert_item(const Frame& F, int it) {
    P0Item I; const int mtx0 = it / 1024 + 1, rr = it % 1024, kb = rr / 64, nb = rr % 64; I.k0 = 128 * kb; I.n0 = 32 * nb;
    const size_t esz = (size_t)2048 * 2048;
    if (mtx0 == 1) { I.W = F.in[I_MWO]; I.WT = F.ws + WS_WO; I.row_off = 0; I.scale = WO8_SCALE; return I; }
    const int mtx = mtx0 - 2, e = mtx / 3, which = mtx % 3;
    if (which == 0)      { I.W = F.in[I_WG] + e * esz; I.WT = F.ws + WS_WGU + (size_t)e * 2 * esz; I.row_off = (I.n0 / 128) * 256 + (I.n0 % 128) - I.n0; I.scale = WG_SCALE; }
    else if (which == 1) { I.W = F.in[I_WU] + e * esz; I.WT = F.ws + WS_WGU + (size_t)e * 2 * esz; I.row_off = (I.n0 / 128) * 256 + 128 + (I.n0 % 128) - I.n0; I.scale = WG_SCALE; }
    else                 { I.W = F.in[I_WD] + e * esz; I.WT = F.ws + WS_WD + (size_t)e * esz; I.row_off = 0; I.scale = WD_SCALE; }
    return I;
}
__device__ __forceinline__ void p0_expert_load(const P0Item& I, f32x4 (&v)[16], int lane) {
#pragma unroll
    for (int i = 0; i < 16; ++i) v[i] = __builtin_nontemporal_load((const f32x4*)(I.W + (size_t)(I.k0 + 8 * i + (lane >> 3)) * 2048 + I.n0 + 4 * (lane & 7)));
}
__device__ __forceinline__ void p0_expert_store(const P0Item& I, const f32x4 (&v)[16], LAS float* scr, int lane) {
#pragma unroll
    for (int i = 0; i < 16; ++i) { LAS float* d = scr + (8 * i + (lane >> 3)) * 33 + 4 * ((lane & 7) ^ (i >> 1)); d[0] = v[i][0] * I.scale; d[1] = v[i][1] * I.scale; d[2] = v[i][2] * I.scale; d[3] = v[i][3] * I.scale; }
    LDS_WAIT(); asm volatile("" ::: "memory");
    const int q = lane & 7;
#pragma unroll
    for (int j = 0; j < 4; ++j) { const int n = (lane >> 3) + 8 * j; const LAS float* sp = scr + (16 * q) * 33 + (n ^ (q << 2)); u32x4 o;
#pragma unroll
        for (int d = 0; d < 4; ++d) { int p = __builtin_amdgcn_cvt_pk_fp8_f32(sp[(4 * d + 0) * 33], sp[(4 * d + 1) * 33], 0, false); p = __builtin_amdgcn_cvt_pk_fp8_f32(sp[(4 * d + 2) * 33], sp[(4 * d + 3) * 33], p, true); o[d] = (unsigned)p; }
        *(GAS u32x4*)(I.WT + (size_t)(I.row_off + I.n0 + n) * 2048 + I.k0 + 16 * q) = o; }
    LDS_WAIT(); asm volatile("" ::: "memory");
}
__device__ __forceinline__ void row_to_bf16(const float* xrow, bf16_t* orow, int lane) {
    const GAS f32x4* xr = (const GAS f32x4*)xrow + lane; GAS u32x2* o8 = (GAS u32x2*)orow + lane;
    f32x4 v[8];
#pragma unroll
    for (int j = 0; j < 8; ++j) v[j] = xr[64 * j];
#pragma unroll
    for (int j = 0; j < 8; ++j) { u32x2 w; w.x = cvt_pk_bf16_c(v[j].x, v[j].y); w.y = cvt_pk_bf16_c(v[j].z, v[j].w); o8[64 * j] = w; }
}
constexpr int CONV_NEXP = 97 * 1024, CONV_KEND = 49;
#define CONV_PRE(ka, kb) do { if (!(F.vcu & 1)) { p0_conv_range(F, ka, kb); __syncthreads(); } } while (0)
#define CONV_POST(ka, kb) do { if (F.vcu & 1) { __syncthreads(); p0_conv_range(F, ka, kb); } } while (0)
#define CONV_KS ((2048 + F.G * NWAVES - 1) / (F.G * NWAVES) - 1)
#define CONV_K0 (1 + CONV_KS)
#define CONV_K1 (19 + CONV_KS)
#define CONV_K3 (31 + CONV_KS)
#define CONV_K4 (39 + CONV_KS)
#define CONV_K6 (43 + CONV_KS)
#define CONV_K9 (1 << 20)
__device__ __forceinline__ void p0_conv_range(Frame& F, int kb, int ke) {
    const int gw = __builtin_amdgcn_readfirstlane(opaque(F.vcu * NWAVES + F.wave)), NGW = F.G * NWAVES;
    LAS float* scr2 = (LAS float*)(F.lds + F.wave * 17408);
    f32x4 va[16], vb[16];
    if (ke > CONV_NEXP / NGW + 2) ke = CONV_NEXP / NGW + 2;
    int it = gw + kb * NGW; const int itend = gw + ke * NGW;
    if (it < CONV_NEXP && it < itend) { P0Item Ia = p0_expert_item(F, it); p0_expert_load(Ia, va, F.lane);
        for (;;) {
            const int itb = it + NGW; const bool hb = itb < CONV_NEXP && itb < itend; P0Item Ib = Ia;
            if (hb) { Ib = p0_expert_item(F, itb); p0_expert_load(Ib, vb, F.lane); }
            p0_expert_store(Ia, va, scr2, F.lane);
            if (!hb) break;
            const int itc = itb + NGW; const bool hc = itc < CONV_NEXP && itc < itend;
            if (hc) { Ia = p0_expert_item(F, itc); p0_expert_load(Ia, va, F.lane); }
            p0_expert_store(Ib, vb, scr2, F.lane);
            if (!hc) break;
            it = itc;
        }
    }
}
struct SItem { const float* W; bf16_t* WT; int N, k0, n0, row_off; float scale; };
__device__ __forceinline__ SItem p0_small_item(const Frame& F, int it) {
    constexpr int I_IN = 32 * 192, I_SQ = 32 * 64;
    SItem I; int r = it;
    if (r < I_IN) { const int kb = r / 192, nb = r % 192, n0 = nb * 32; I.W = F.in[I_WIN]; I.N = 6144; I.k0 = 64 * kb; I.n0 = n0;
        if (n0 < 2048) { I.WT = (bf16_t*)(F.ws + WS_WINA); I.row_off = 0; I.scale = n0 < 1024 ? QSCALE : 1.f; }
        else if (n0 < 3072) { I.WT = (bf16_t*)(F.ws + WS_WINV); I.row_off = -2048; I.scale = 1.f; }
        else { I.WT = (bf16_t*)(F.ws + WS_WINA); I.row_off = -1024; I.scale = 1.f; }
        return I; }
    r -= I_IN;
    if (r < I_SQ) { I.W = F.in[I_WOUT]; I.N = 2048; I.k0 = 64 * (r / 64); I.n0 = 32 * (r % 64); I.WT = (bf16_t*)(F.ws + WS_WOUT); I.row_off = 0; I.scale = 1.f; return I; }
    r -= I_SQ;
    I.W = F.in[I_MWKV]; I.N = 4096; I.k0 = 64 * (r / 128); I.n0 = 32 * (r % 128); I.WT = (bf16_t*)(F.ws + WS_WKV); I.row_off = 0; I.scale = 1.f; return I;
}
__device__ __forceinline__ void p0_small_load(const SItem& I, f32x4 (&v)[8], int lane) {
#pragma unroll
    for (int i = 0; i < 8; ++i) v[i] = __builtin_nontemporal_load((const f32x4*)(I.W + (size_t)(I.k0 + 8 * i + (lane >> 3)) * I.N + I.n0 + 4 * (lane & 7)));
}
__device__ __forceinline__ void p0_small_store(const SItem& I, const f32x4 (&v)[8], LAS float* scr, int lane) {
#pragma unroll
    for (int i = 0; i < 8; ++i) { LAS float* d = scr + (8 * i + (lane >> 3)) * 33 + 4 * (lane & 7); d[0] = v[i][0] * I.scale; d[1] = v[i][1] * I.scale; d[2] = v[i][2] * I.scale; d[3] = v[i][3] * I.scale; }
    LDS_WAIT(); asm volatile("" ::: "memory");
    const int c = lane & 7;
#pragma unroll
    for (int j = 0; j < 4; ++j) { const int n = (lane >> 3) + 8 * j; const LAS float* sp = scr + (8 * c) * 33 + n;
        u32x4 o; o.x = cvt_pk_bf16_c(sp[0 * 33], sp[1 * 33]); o.y = cvt_pk_bf16_c(sp[2 * 33], sp[3 * 33]); o.z = cvt_pk_bf16_c(sp[4 * 33], sp[5 * 33]); o.w = cvt_pk_bf16_c(sp[6 * 33], sp[7 * 33]);
        *(GAS u32x4*)(I.WT + (size_t)(I.row_off + I.n0 + n) * 2048 + I.k0 + 8 * c) = o; }
    LDS_WAIT(); asm volatile("" ::: "memory");
}
__device__ __forceinline__ void p0_prologue(Frame& F) {
    LAS float* scr = (LAS float*)(F.lds + F.wave * 17408);
    const int gw = F.vcu * NWAVES + F.wave, NGW = F.G * NWAVES;
    bf16_t* winA = (bf16_t*)(F.ws + WS_WINA); bf16_t* winV = (bf16_t*)(F.ws + WS_WINV);
    constexpr int I_IN = 32 * 192, I_SQ = 32 * 64, I_KV = 32 * 128;
    constexpr int NSMALL = I_IN + 1 * I_SQ + I_KV;
    if (gw < NSMALL) {
        f32x4 va[8], vb[8]; int it = gw; SItem Ia = p0_small_item(F, it); p0_small_load(Ia, va, F.lane);
        for (;;) {
            const int itb = it + NGW; const bool hb = itb < NSMALL; SItem Ib = Ia;
            if (hb) { Ib = p0_small_item(F, itb); p0_small_load(Ib, vb, F.lane); }
            p0_small_store(Ia, va, scr, F.lane);
            if (!hb) break;
            const int itc = itb + NGW; const bool hc = itc < NSMALL;
            if (hc) { Ia = p0_small_item(F, itc); p0_small_load(Ia, va, F.lane); }
            p0_small_store(Ib, vb, scr, F.lane);
            if (!hc) break;
            it = itc;
        }
    }
    p0_conv_range(F, 0, CONV_K0);
    {
        const float* xin = F.in[I_X]; bf16_t* xb = (bf16_t*)(F.ws + WS_R1);
        for (int m = gw; m < NTOK; m += 2 * NGW) { const int m2 = m + NGW; const bool h2 = m2 < NTOK;
            const GAS f32x4* x1 = (const GAS f32x4*)(xin + (size_t)m * DM) + F.lane; const GAS f32x4* x2 = (const GAS f32x4*)(xin + (size_t)(h2 ? m2 : m) * DM) + F.lane;
            f32x4 a[8], b[8];
#pragma unroll
            for (int j = 0; j < 8; ++j) a[j] = __builtin_nontemporal_load(x1 + 64 * j);
#pragma unroll
            for (int j = 0; j < 8; ++j) b[j] = __builtin_nontemporal_load(x2 + 64 * j);
            GAS u32x2* o1 = (GAS u32x2*)(xb + (size_t)m * DM) + F.lane; GAS u32x2* o2 = (GAS u32x2*)(xb + (size_t)m2 * DM) + F.lane;
#pragma unroll
            for (int j = 0; j < 8; ++j) { u32x2 w; w.x = cvt_pk_bf16_c(a[j].x, a[j].y); w.y = cvt_pk_bf16_c(a[j].z, a[j].w); o1[64 * j] = w; }
            if (h2) {
#pragma unroll
                for (int j = 0; j < 8; ++j) { u32x2 w; w.x = cvt_pk_bf16_c(b[j].x, b[j].y); w.y = cvt_pk_bf16_c(b[j].z, b[j].w); o2[64 * j] = w; } }
        }
    }
    {
        const float* wq = F.in[I_MWQ]; unsigned char* wqn = F.ws + WS_WQ;
        for (int m = gw; m < DM; m += NGW) { const GAS f32x4* xr = (const GAS f32x4*)(wq + (size_t)m * DM) + F.lane; GAS unsigned* o4 = (GAS unsigned*)(wqn + (size_t)m * DM) + F.lane;
            f32x4 v[8];
#pragma unroll
            for (int j = 0; j < 8; ++j) v[j] = __builtin_nontemporal_load(xr + 64 * j);
#pragma unroll
            for (int j = 0; j < 8; ++j) { int p = __builtin_amdgcn_cvt_pk_fp8_f32(v[j].x * WQ8_SCALE, v[j].y * WQ8_SCALE, 0, false); p = __builtin_amdgcn_cvt_pk_fp8_f32(v[j].z * WQ8_SCALE, v[j].w * WQ8_SCALE, p, true); o4[64 * j] = (unsigned)p; } }
    }
    for (int m = gw; m < BATCH * NMEM; m += NGW) row_to_bf16(F.in[I_MEM] + (size_t)m * DM, (bf16_t*)(F.ws + WS_MEMB) + (size_t)m * DM, F.lane);
    { bf16_t* rt = (bf16_t*)(F.ws + WS_ROUTT); const float* rw = F.in[I_RW]; const float* g2 = F.in[I_LN2G];
      for (int i = gw * 64 + F.lane; i < 2048 * 32; i += NGW * 64) { const int k = i >> 5, e = i & 31; const float w = rw[i] * g2[k]; const unsigned wh = f2bf(w);
          rt[e * 2048 + k] = (bf16_t)wh; rt[32 * 2048 + e * 2048 + k] = (bf16_t)f2bf(w - __uint_as_float(wh << 16)); } }
    for (int v = F.vcu; v < 64; v += F.G) {
        const int e = v & 31; const float* vec = (v >> 5) ? F.in[I_LN2B] : F.in[I_LN2G]; const float* rw = F.in[I_RW];
        float a = 0.f;
        for (int k = F.tid; k < 2048; k += NWAVES * 64) a += vec[k] * rw[k * 32 + e];
        a = wave_sum(a);
        __syncthreads();
        if (F.lane == 0) ((LAS float*)(F.lds + F.wave * 17408))[0] = a;
        __syncthreads();
        if (F.tid == 0) { float t = 0.f; for (int w = 0; w < NWAVES; ++w) t += ((LAS float*)(F.lds + w * 17408))[0]; if (v >> 5) t += F.in[I_RB][e]; ((float*)(F.ctl))[CW_RC + v] = t; }
    }
}

struct ProbP1 {
    static constexpr bool META = false, GATHER = false, FP8 = false;
    int Kb, lda, ldb, G, c;
    const bf16_t *xb, *winA, *winV, *wkvT, *memb;
    static constexpr int U0 = 128 * 20, U1 = U0 + 4 * 128;
    __device__ __forceinline__ bool next(int i, pg8::Unit& u) const {
        const int L = i * G + c; if (L >= U1) return false;
        const int w = pg8::xcd_chunk(L, U1);
        if (w < U0) { u.g = 0; pg8::tile_of(w, 128, 20, 8, u.pm, u.pn); }
        else { u.g = 1; pg8::tile_of(w - U0, 4, 128, 4, u.pm, u.pn); }
        return true;
    }
    __device__ __forceinline__ const char* a_base(const pg8::Unit& u) const {
        const bf16_t* p = u.g == 0 ? xb : winV;
        return (const char*)(p + (size_t)u.pm * 256 * 2048); }
    __device__ __forceinline__ const char* b_base(const pg8::Unit& u) const {
        const bf16_t* p = u.g == 0 ? winA : xb;
        return (const char*)(p + (size_t)u.pn * 256 * 2048); }
};
struct ProbKV {
    static constexpr bool META = false, GATHER = false, FP8 = false;
    int Kb, lda, ldb, c;
    const bf16_t *wkvT, *memb;
    __device__ __forceinline__ bool next(int i, pg8::Unit& u) const { if (i > 0 || c >= 64) return false; u.g = 2; u.pm = c >> 4; u.pn = c & 15; return true; }
    __device__ __forceinline__ const char* a_base(const pg8::Unit& u) const { return (const char*)(memb + (size_t)u.pm * 256 * 2048); }
    __device__ __forceinline__ const char* b_base(const pg8::Unit& u) const { return (const char*)(wkvT + (size_t)u.pn * 256 * 2048); }
};
struct EpiP1 {
    static constexpr bool PERM = true;
    bf16_t *proj, *VT; unsigned char *kmem, *vmem; gu32* ctl; LAS float* kt;
    __device__ __forceinline__ void operator()(const pg8::Acc& acc, const pg8::Unit& u, int wr, int wc, int fr_, int fq) const {
        if (u.g == 0 && (u.pn >> 2) == 1) {
            const int fr = opaque(fr_);
#pragma unroll
            for (int ai = 0; ai < 2; ++ai)
#pragma unroll
                for (int m = 0; m < 4; ++m) { const int row = ai * 128 + wr * 64 + m * 16 + fr; bf16_t* rowp = proj + (size_t)(u.pm * 256 + row) * PROJ_N + u.pn * 256 + wc * 32 + 8 * fq;
#pragma unroll
                    for (int bj = 0; bj < 2; ++bj) { const f32x4 v0 = acc[ai][bj][m][0], v1 = acc[ai][bj][m][1];
                        u32x4 w; w.x = cvt_pk_bf16_c(v0[0], v0[1]); w.y = cvt_pk_bf16_c(v0[2], v0[3]); w.z = cvt_pk_bf16_c(v1[0], v1[1]); w.w = cvt_pk_bf16_c(v1[2], v1[3]);
                        *(u32x4*)(rowp + bj * 128) = w;
                        float ss = 0.f;
#pragma unroll
                        for (int j = 0; j < 4; ++j) ss += bflo(w[j]) * bflo(w[j]) + bfhi(w[j]) * bfhi(w[j]);
                        ss += __shfl_xor(ss, 16); ss += __shfl_xor(ss, 32);
                        if (fq == 0) kt[row * 8 + bj * 4 + wc] = ss; } }
            asm volatile("s_waitcnt lgkmcnt(0)" ::: "memory"); __builtin_amdgcn_s_barrier(); asm volatile("" ::: "memory");
            if (wr == 0) { const int row = wc * 64 + (fr + 16 * fq); const f32x4 a = *(const LAS f32x4*)(kt + row * 8), b = *(const LAS f32x4*)(kt + row * 8 + 4);
                float g0 = a.x + a.y, g1 = a.z + a.w, g2 = b.x + b.y, g3 = b.z + b.w;
                g0 = wave_max(g0); g1 = wave_max(g1); g2 = wave_max(g2); g3 = wave_max(g3);
                if (fr + 16 * fq == 0) { unsigned* kn = (unsigned*)(ctl + CW_KNMAX) + (u.pm >> 5) * 16 + (u.pn - 4) * 4;
                    atomicMax(kn, __float_as_uint(g0)); atomicMax(kn + 1, __float_as_uint(g1)); atomicMax(kn + 2, __float_as_uint(g2)); atomicMax(kn + 3, __float_as_uint(g3)); } }
            return; }
        if (u.g == 1) {
            const int fr = opaque(fr_);
#pragma unroll
            for (int ai = 0; ai < 2; ++ai)
#pragma unroll
                for (int m = 0; m < 4; ++m) { const int dg = u.pm * 256 + ai * 128 + wr * 64 + m * 16 + fr;
#pragma unroll
                    for (int bj = 0; bj < 2; ++bj) { const int tok = u.pn * 256 + bj * 128 + wc * 32 + 8 * fq, b = tok >> 13, t = tok & (SEQ - 1);
                        bf16_t* p = VT + ((size_t)((b * NH + (dg >> 7)) * 128 + (t >> 6)) * 8192 + (dg & 127) * 64 + (t & 63));
                        const f32x4 v0 = acc[ai][bj][m][0], v1 = acc[ai][bj][m][1];
                        u32x4 w; w.x = cvt_pk_bf16_c(v0[0], v0[1]); w.y = cvt_pk_bf16_c(v0[2], v0[3]); w.z = cvt_pk_bf16_c(v1[0], v1[1]); w.w = cvt_pk_bf16_c(v1[2], v1[3]);
                        *(u32x4*)p = w; } }
            return; }
        if (u.g == 2) { pg8::store_tile_fp8(acc, (u.pn < 8 ? kmem : vmem) + (size_t)u.pm * 256 * 2048 + (size_t)(u.pn & 7) * 256, 2048, 1.0f, wr, wc, fr_, fq); return; }
        pg8::store_tile_bf16(acc, proj + (size_t)u.pm * 256 * PROJ_N + (size_t)u.pn * 256, PROJ_N, wr, wc, fr_, fq);
    }
};

struct ProbDense {
    static constexpr bool META = false, GATHER = false, FP8 = false;
    int Kb, lda, ldb, G, c, nM, nN;
    const bf16_t *A, *Bt;
    __device__ __forceinline__ bool next(int i, pg8::Unit& u) const {
        const int L = i * G + c, nwg = nM * nN; if (L >= nwg) return false;
        u.g = 0; pg8::tile_of(pg8::xcd_chunk(L, nwg), nM, nN, 8, u.pm, u.pn); return true; }
    __device__ __forceinline__ const char* a_base(const pg8::Unit& u) const { return (const char*)A + (size_t)u.pm * 256 * lda; }
    __device__ __forceinline__ const char* b_base(const pg8::Unit& u) const { return (const char*)Bt + (size_t)u.pn * 256 * ldb; }
};
struct ProbDenseQ {
    static constexpr bool META = false, GATHER = false, FP8 = true;
    int Kb, lda, ldb, G, c, nM, nN;
    const unsigned char *A, *Bt;
    __device__ __forceinline__ bool next(int i, pg8::Unit& u) const {
        const int L = i * G + c, nwg = nM * nN; if (L >= nwg) return false;
        u.g = 0; pg8::tile_of(pg8::xcd_chunk(L, nwg), nM, nN, 8, u.pm, u.pn); return true; }
    __device__ __forceinline__ const char* a_base(const pg8::Unit& u) const { return (const char*)A + (size_t)u.pm * 256 * lda; }
    __device__ __forceinline__ const char* b_base(const pg8::Unit& u) const { return (const char*)Bt + (size_t)u.pn * 256 * ldb; }
};
struct EpiFp8S {
    static constexpr bool PERM = true;
    unsigned char* O; size_t ldc; float scale;
    __device__ __forceinline__ void operator()(const pg8::Acc& acc, const pg8::Unit& u, int wr, int wc, int fr, int fq) const {
        pg8::store_tile_fp8(acc, O + (size_t)u.pm * 256 * ldc + (size_t)u.pn * 256, ldc, scale, wr, wc, fr, fq); }
};
struct EpiBf16S {
    static constexpr bool PERM = true;
    bf16_t* O; size_t ldc; float scale;
    __device__ __forceinline__ void operator()(pg8::Acc& acc, const pg8::Unit& u, int wr, int wc, int fr, int fq) const {
#pragma unroll
        for (int ai = 0; ai < 2; ++ai)
#pragma unroll
            for (int bj = 0; bj < 2; ++bj)
#pragma unroll
                for (int m = 0; m < 4; ++m)
#pragma unroll
                    for (int n = 0; n < 2; ++n) acc[ai][bj][m][n] = acc[ai][bj][m][n] * scale;
        pg8::store_tile_bf16(acc, O + (size_t)u.pm * 256 * ldc + (size_t)u.pn * 256, ldc, wr, wc, fr, fq); }
};
struct EpiBf16 {
    static constexpr bool PERM = true;
    bf16_t* O; size_t ldc;
    __device__ __forceinline__ void operator()(const pg8::Acc& acc, const pg8::Unit& u, int wr, int wc, int fr, int fq) const {
        pg8::store_tile_bf16(acc, O + (size_t)u.pm * 256 * ldc + (size_t)u.pn * 256, ldc, wr, wc, fr, fq); }
};
struct EpiResB {
    static constexpr bool PERM = true;
    const bf16_t* res; bf16_t* out;
    __device__ __forceinline__ void operator()(const pg8::Acc& acc, const pg8::Unit& u, int wr, int wc, int fr_, int fq) const {
        const int fr = opaque(fr_);
        u32x4 rv[2][4][2];
#pragma unroll
        for (int ai = 0; ai < 2; ++ai)
#pragma unroll
            for (int m = 0; m < 4; ++m) { const size_t off = (size_t)(u.pm * 256 + ai * 128 + wr * 64 + m * 16 + fr) * DM + u.pn * 256 + wc * 32 + 8 * fq;
#pragma unroll
                for (int bj = 0; bj < 2; ++bj) rv[ai][m][bj] = *(const u32x4*)(res + off + bj * 128); }
        __builtin_amdgcn_sched_barrier(0);
#pragma unroll
        for (int ai = 0; ai < 2; ++ai) {
#pragma unroll
            for (int m = 0; m < 4; ++m) { const size_t off = (size_t)(u.pm * 256 + ai * 128 + wr * 64 + m * 16 + fr) * DM + u.pn * 256 + wc * 32 + 8 * fq;
#pragma unroll
                for (int bj = 0; bj < 2; ++bj) { const u32x4 r = rv[ai][m][bj]; const f32x4 v0 = acc[ai][bj][m][0], v1 = acc[ai][bj][m][1];
                    u32x4 w; w.x = cvt_pk_bf16_c(v0[0] + ALPHA * bflo(r.x), v0[1] + ALPHA * bfhi(r.x)); w.y = cvt_pk_bf16_c(v0[2] + ALPHA * bflo(r.y), v0[3] + ALPHA * bfhi(r.y));
                    w.z = cvt_pk_bf16_c(v1[0] + ALPHA * bflo(r.z), v1[1] + ALPHA * bfhi(r.z)); w.w = cvt_pk_bf16_c(v1[2] + ALPHA * bflo(r.w), v1[3] + ALPHA * bfhi(r.w));
                    *(u32x4*)(out + off + bj * 128) = w; } }
            __builtin_amdgcn_sched_barrier(0); }
    }
};

struct EpiResLNB {
    static constexpr bool PERM = true;
    const bf16_t* z; bf16_t* out; const float* stats; const float* gam; const float* bet; float ascale;
    __device__ __forceinline__ void operator()(const pg8::Acc& acc, const pg8::Unit& u, int wr, int wc, int fr_, int fq) const {
        const int fr = opaque(fr_);
        const int col0 = u.pn * 256 + wc * 32 + 8 * fq;
        f32x4 gv[2][2], bv[2][2];
#pragma unroll
        for (int bj = 0; bj < 2; ++bj)
#pragma unroll
            for (int n = 0; n < 2; ++n) { gv[bj][n] = *(const f32x4*)(gam + col0 + bj * 128 + n * 4) * ALPHA; bv[bj][n] = *(const f32x4*)(bet + col0 + bj * 128 + n * 4) * ALPHA; }
#pragma unroll
        for (int ai = 0; ai < 2; ++ai) {
            u32x4 rv[4][2]; float mean[4], rstd[4];
#pragma unroll
            for (int m = 0; m < 4; ++m) { const int row = u.pm * 256 + ai * 128 + wr * 64 + m * 16 + fr; const size_t off = (size_t)row * DM + col0;
                mean[m] = stats[2 * row]; rstd[m] = stats[2 * row + 1];
#pragma unroll
                for (int bj = 0; bj < 2; ++bj) rv[m][bj] = *(const u32x4*)(z + off + bj * 128); }
            __builtin_amdgcn_sched_barrier(0);
#pragma unroll
            for (int m = 0; m < 4; ++m) { const int row = u.pm * 256 + ai * 128 + wr * 64 + m * 16 + fr; const size_t off = (size_t)row * DM + col0;
#pragma unroll
                for (int bj = 0; bj < 2; ++bj) { const u32x4 r = rv[m][bj];
                    const f32x4 r0 = {bflo(r.x), bfhi(r.x), bflo(r.y), bfhi(r.y)}, r1 = {bflo(r.z), bfhi(r.z), bflo(r.w), bfhi(r.w)};
                    const f32x4 o0 = acc[ai][bj][m][0] * ascale + ((r0 - mean[m]) * rstd[m]) * gv[bj][0] + bv[bj][0], o1 = acc[ai][bj][m][1] * ascale + ((r1 - mean[m]) * rstd[m]) * gv[bj][1] + bv[bj][1];
                    u32x4 w; w.x = cvt_pk_bf16_c(o0[0], o0[1]); w.y = cvt_pk_bf16_c(o0[2], o0[3]); w.z = cvt_pk_bf16_c(o1[0], o1[1]); w.w = cvt_pk_bf16_c(o1[2], o1[3]);
                    *(u32x4*)(out + off + bj * 128) = w; } }
            __builtin_amdgcn_sched_barrier(0); }
    }
};

template <int T>
__device__ __forceinline__ void p2_conv(Frame& F) {
    const bf16_t* proj = (const bf16_t*)(F.ws + WS_PROJ); bf16_t* mix = (bf16_t*)(F.ws + WS_MIX);
    const float* cw = F.in[I_CONVW];
    const int gt = opaque(F.vcu * 512) + F.tid, NT = F.G * 512;
    for (int it = gt; it < (NTOK / T) * 128; it += NT) {
        const int tb8 = it >> 7, cg = it & 127, c0 = cg * 8, tok0 = tb8 * T, t0 = tok0 & (SEQ - 1);
        const bf16_t* row0 = proj + (size_t)tok0 * PROJ_N;
        const f32x4 w0a = *(const f32x4*)(cw + c0), w0b = *(const f32x4*)(cw + c0 + 4), w1a = *(const f32x4*)(cw + CW + c0), w1b = *(const f32x4*)(cw + CW + c0 + 4), w2a = *(const f32x4*)(cw + 2 * CW + c0), w2b = *(const f32x4*)(cw + 2 * CW + c0 + 4);
        const float w0[8] = {w0a[0], w0a[1], w0a[2], w0a[3], w0b[0], w0b[1], w0b[2], w0b[3]};
        const float w1[8] = {w1a[0], w1a[1], w1a[2], w1a[3], w1b[0], w1b[1], w1b[2], w1b[3]};
        const float w2[8] = {w2a[0], w2a[1], w2a[2], w2a[3], w2b[0], w2b[1], w2b[2], w2b[3]};
        u32x4 cv[T + 2], uv[T + 2], gv[T];
#pragma unroll
        for (int r = 0; r < T + 2; ++r) { const int t = t0 - 1 + r; const bool ok = (t >= 0) && (t < SEQ); const bf16_t* rp = row0 + (ptrdiff_t)(r - 1) * PROJ_N;
            cv[r] = ok ? *(const u32x4*)(rp + 3072 + c0) : (u32x4){0, 0, 0, 0}; uv[r] = ok ? *(const u32x4*)(rp + 4096 + c0) : (u32x4){0, 0, 0, 0}; }
#pragma unroll
        for (int r = 0; r < T; ++r) gv[r] = *(const u32x4*)(row0 + (size_t)r * PROJ_N + 2048 + c0);
        float pm[8], pc[8], pn[8];
#pragma unroll
        for (int j = 0; j < 4; ++j) { pm[2 * j] = bflo(cv[0][j]) * bflo(uv[0][j]); pm[2 * j + 1] = bfhi(cv[0][j]) * bfhi(uv[0][j]); pc[2 * j] = bflo(cv[1][j]) * bflo(uv[1][j]); pc[2 * j + 1] = bfhi(cv[1][j]) * bfhi(uv[1][j]); }
#pragma unroll
        for (int r = 0; r < T; ++r) {
#pragma unroll
            for (int j = 0; j < 4; ++j) { pn[2 * j] = bflo(cv[r + 2][j]) * bflo(uv[r + 2][j]); pn[2 * j + 1] = bfhi(cv[r + 2][j]) * bfhi(uv[r + 2][j]); }
            u32x4 o;
#pragma unroll
            for (int j = 0; j < 4; ++j) {
                const float lo = bflo(gv[r][j]) * (w0[2 * j] * pm[2 * j] + w1[2 * j] * pc[2 * j] + w2[2 * j] * pn[2 * j]);
                const float hi = bfhi(gv[r][j]) * (w0[2 * j + 1] * pm[2 * j + 1] + w1[2 * j + 1] * pc[2 * j + 1] + w2[2 * j + 1] * pn[2 * j + 1]);
                o[j] = cvt_pk_bf16_c(lo, hi); }
            *(u32x4*)(mix + (size_t)(tok0 + r) * DM + AW + c0) = o;
#pragma unroll
            for (int j = 0; j < 8; ++j) { pm[j] = pc[j]; pc[j] = pn[j]; }
        }
    }
}
__device__ __forceinline__ int pi_swap(int r) { return (r & ~12) | ((r & 4) << 1) | ((r & 8) >> 1); }
__device__ __forceinline__ void glds16(const void* sbase, unsigned voff, unsigned lds_dst) { unsigned keep;
    asm volatile("s_mov_b32 %0, m0\n\ts_mov_b32 m0, %3\n\ts_nop 0\n\tglobal_load_lds_dwordx4 %1, %2\n\ts_mov_b32 m0, %0" : "=&s"(keep) : "v"(voff), "s"(sbase), "s"(lds_dst) : "memory"); }
#define ATT_WAIT_BAR() asm volatile("s_waitcnt vmcnt(0) lgkmcnt(0)\n\ts_barrier" ::: "memory")
__device__ __forceinline__ int att_take(gu32* aq, int myq, int& qk) {
    while (qk < 8) { const int q = (myq + qk) & 7; const unsigned t = __hip_atomic_fetch_add((unsigned*)(aq + q * 32), 1u, RLX_AGENT); if (t < 256u) return q * 256 + (int)t; ++qk; }
    return -1;
}
template <class Mid>
__device__ __forceinline__ void p3_attention(Frame& F, const Mid& after_first) {
    const bf16_t* proj = (const bf16_t*)(F.ws + WS_PROJ); const bf16_t* VT = (const bf16_t*)(F.ws + WS_VT); bf16_t* mix = (bf16_t*)(F.ws + WS_MIX);
    const int lane = F.lane, wid = F.wave, g = wid & 3, s = wid >> 2, r32 = lane & 31, hi = lane >> 5;
    LAS unsigned char* lds = F.lds;
    const unsigned lds0 = (unsigned)(size_t)lds;
    LAS float* red = (LAS float*)(F.lds + XTRA_OFF);
    gu32* aq = F.ctl + CW_ATTQ; const int myq = (F.vcu * 8) / F.G; int qk = 0, ndone = 0;
    LAS int* qslot = (LAS int*)(F.lds + XTRA_OFF + 128);
    LAS float* atab = (LAS float*)(F.lds + XTRA_OFF + 10240);
    { if (F.tid < 128) atab[F.tid] = F.in[I_SUBLN][F.tid];
      else if (F.tid < 192) atab[64 + F.tid] = __uint_as_float(__hip_atomic_load((const unsigned*)(F.ctl + CW_KNMAX) + (F.tid - 128), RLX_AGENT));
      const float a = wave_sum(F.in[I_LQ1][lane] * F.in[I_LK1][lane]), b2 = wave_sum(F.in[I_LQ2][lane] * F.in[I_LK2][lane]);
      if (F.tid == 0) atab[128] = __expf(a) - __expf(b2) + LAMBDA_INIT; }
    if (F.tid == 0) qslot[0] = att_take(aq, myq, qk);
    __syncthreads();
    int unit = qslot[0];
    while (unit >= 0) {
    {
        const int pair = (unit >> 8) * 32 + (unit & 31), h = 7 - ((unit & 255) >> 5), b = pair >> 6, qt = pair & 63, q0 = qt * 128;
        unsigned tkt = 0u;
        if (F.tid == 0 && qk < 8) tkt = __hip_atomic_fetch_add((unsigned*)(aq + ((myq + qk) & 7) * 32), 1u, RLX_AGENT);
    const int ol = opaque(lane);
    int koff[2], voff[2]; unsigned kdst[2], vdst[2];
#pragma unroll
    for (int j = 0; j < 2; ++j) { const int p = 2 * wid + j; const int row = 4 * p + (ol >> 4), c = (ol & 15) ^ (row & 15); koff[j] = (row * PROJ_N + c * 8) * 2;
        const int d = 8 * p + (ol >> 3), cv = (ol & 7) ^ ((d >> 1) & 7); voff[j] = (d * 64 + cv * 8) * 2; kdst[j] = (unsigned)(p * 1024); vdst[j] = (unsigned)(16384 + p * 1024); }
    const int kfo[2] = { pi_swap(ol & 31) * 256, (32 + pi_swap(ol & 31)) * 256 };
    const int krx = pi_swap(ol & 31) & 15;
        const float slope2 = exp2f(-(float)(h + 1)) * LOG2E;
        unsigned bw0;
        { const float x = slope2 * (float)pi_swap(r32); const unsigned xh = f2bf(x); const float xr = x - __uint_as_float(xh << 16); bw0 = hi ? 0u : (xh | (f2bf(xr) << 16)); }
        const bf16_t* qrow = proj + (size_t)(b * SEQ + q0 + 32 * g + r32) * PROJ_N + h * 128 + s * 64 + 8 * hi;
        bf16x8 qf[4]; float qn = 0.f;
        u32x4 qw4[4], kw4[4];
#pragma unroll
        for (int d0 = 0; d0 < 4; ++d0) qw4[d0] = *(const u32x4*)(qrow + 16 * d0);
#pragma unroll
        for (int d0 = 0; d0 < 4; ++d0) kw4[d0] = *(const u32x4*)(qrow + 1024 + 16 * d0);
        __builtin_amdgcn_sched_barrier(0);
#pragma unroll
        for (int d0 = 0; d0 < 4; ++d0) { const u32x4 w = qw4[d0]; qf[d0] = __builtin_bit_cast(bf16x8, w);
#pragma unroll
            for (int j = 0; j < 4; ++j) qn += bflo(w[j]) * bflo(w[j]) + bfhi(w[j]) * bfhi(w[j]); }
        qn += __shfl_xor(qn, 32); qn = wave_max(qn);
        float sself = 0.f;
#pragma unroll
        for (int d0 = 0; d0 < 4; ++d0) { const u32x4 kw = kw4[d0]; const u32x4 qw = qw4[d0];
#pragma unroll
            for (int j = 0; j < 4; ++j) sself += bflo(kw[j]) * bflo(qw[j]) + bfhi(kw[j]) * bfhi(qw[j]); }
        sself += __shfl_xor(sself, 32); const float srow = sself; sself = -wave_max(-sself);
        if (lane == 0) { red[wid] = qn; red[8 + wid] = sself; }
        __syncthreads();
        float bnd, ubs;
        { const float k0 = atab[192 + b * 16 + h * 2], k1 = atab[193 + b * 16 + h * 2];
          const float q0m = fmaxf(fmaxf(red[0], red[1]), fmaxf(red[2], red[3])), q1m = fmaxf(fmaxf(red[4], red[5]), fmaxf(red[6], red[7]));
          const float l0 = fminf(fminf(red[8], red[9]), fminf(red[10], red[11])), l1 = fminf(fminf(red[12], red[13]), fminf(red[14], red[15]));
          const float ub0 = sqrtf(q0m * k0), ub1 = sqrtf(q1m * k1); ubs = s ? ub1 : ub0; bnd = fmaxf(ub0 - l0, ub1 - l1); }
        int W = (int)((ATT_THR + bnd) / slope2) + 1; W = __builtin_amdgcn_readfirstlane(W);
        int kv_lo = q0 - W; kv_lo = kv_lo < 0 ? 0 : (kv_lo & ~63);
        int kv_hi = q0 + 128 + W; kv_hi = kv_hi > SEQ ? SEQ : ((kv_hi + 63) & ~63);
        const int ntile = (kv_hi - kv_lo) >> 6;
        const bf16_t* kg0 = proj + (size_t)(b * SEQ + kv_lo) * PROJ_N + 1024 + h * 128;
        const bf16_t* vg0 = VT + (size_t)((b * NH + h) * 128 + (kv_lo >> 6)) * 8192;
#define ATT_DMA(t) do { const unsigned sl_ = lds0 + (unsigned)(((t) & 3) * 32768); _Pragma("unroll") for (int j = 0; j < 2; ++j) { \
            glds16(kg0 + (size_t)(t) * 64 * PROJ_N, (unsigned)koff[j], (unsigned)__builtin_amdgcn_readfirstlane(sl_ + kdst[j])); \
            glds16(vg0 + (size_t)(t) * 8192, (unsigned)voff[j], (unsigned)__builtin_amdgcn_readfirstlane(sl_ + vdst[j])); } } while (0)
        f32x16 o[4]; o[0] = f32x16{}; o[1] = f32x16{}; o[2] = f32x16{}; o[3] = f32x16{};
        const float mref = fmaxf(srow, ubs - 100.0f); float lsum = 0.f;
        const float qpos = (float)(q0 + 32 * g + r32); const int qw0 = q0 + 32 * g;
        f32x16 S[2];
#define ATT_SB() __builtin_amdgcn_sched_barrier(0)
#define ATT_KLD(dst, blk, i) do { const LAS unsigned char* kb_ = lds + ((i) & 3) * 32768; _Pragma("unroll") for (int d0 = 0; d0 < 4; ++d0) dst[d0] = *(const LAS bf16x8*)(kb_ + kfo[blk] + (((s * 8 + 2 * d0 + hi) ^ krx) << 4)); } while (0)
#define ATT_KMM(src, blk) do { f32x16 a_; const float c0_ = -(float)sg[blk] * slope2 * (qpos - (float)(kb0 + 32 * (blk))) - mref; _Pragma("unroll") for (int r = 0; r < 16; ++r) a_[r] = c0_; \
            _Pragma("unroll") for (int d0 = 0; d0 < 4; ++d0) a_ = __builtin_amdgcn_mfma_f32_32x32x16_bf16(src[d0], qf[d0], a_, 0, 0, 0); \
            { u32x4 bf_; bf_.x = sg[blk] == 0 ? 0u : (sg[blk] > 0 ? bw0 : (bw0 ^ 0x80008000u)); bf_.y = 0u; bf_.z = 0u; bf_.w = 0u; u32x4 on_; on_.x = 0x3f803f80u; on_.y = 0u; on_.z = 0u; on_.w = 0u; \
              a_ = __builtin_amdgcn_mfma_f32_32x32x16_bf16(__builtin_bit_cast(bf16x8, bf_), __builtin_bit_cast(bf16x8, on_), a_, 0, 0, 0); } \
            S[blk] = a_; } while (0)
#define ATT_SG(i) const int kb0 = kv_lo + 64 * (i); int sg[2]; _Pragma("unroll") for (int blk = 0; blk < 2; ++blk) { const int kb_ = kb0 + 32 * blk; sg[blk] = (kb_ + 31 < qw0) ? 1 : ((kb_ > qw0 + 31) ? -1 : 0); }
#define ATT_VLD(dst, ks, i) do { const LAS unsigned char* vb_ = lds + (((i) - 1) & 3) * 32768 + 16384; _Pragma("unroll") for (int d = 0; d < 4; ++d) { const int dd_ = 32 * d + r32; dst[d] = *(const LAS bf16x8*)(vb_ + dd_ * 128 + (((2 * (ks) + hi) ^ ((dd_ >> 1) & 7)) << 4)); } } while (0)
#define ATT_BAR(dma) do { if (dma) asm volatile("s_waitcnt vmcnt(4) lgkmcnt(0)\n\ts_barrier" ::: "memory"); else ATT_WAIT_BAR(); } while (0)
#define ATT_SLICE(PN, j) do { const int blk_ = (j) >> 3, r_ = 2 * ((j) & 7); const float s0_ = S[blk_][r_], s1_ = S[blk_][r_ + 1]; \
            const float e0_ = __builtin_amdgcn_exp2f(s0_), e1_ = __builtin_amdgcn_exp2f(s1_); lsa_ += e0_; lsb_ += e1_; PN[(j) >> 2][(j) & 3] = cvt_pk_bf16_c(e0_, e1_); } while (0)
#define ATT_MIDBIAS(i) do { const float dq_ = qpos - (float)(kv_lo + (i) * 64 + 8 * hi); _Pragma("unroll") for (int blk = 0; blk < 2; ++blk) { if (sg[blk] == 0) { \
            _Pragma("unroll") for (int r = 0; r < 16; ++r) { const float tt_ = dq_ - (float)(32 * blk + 16 * (r >> 3) + (r & 7)); S[blk][r] = S[blk][r] - slope2 * fabsf(tt_); } } } } while (0)
#define ATT_FINAL() do { lsum += lsa_ + lsb_; } while (0)
#define ATT_PVG(PC, g) do { _Pragma("unroll") for (int d = 0; d < 4; ++d) o[d] = __builtin_amdgcn_mfma_f32_32x32x16_bf16(va[d], __builtin_bit_cast(bf16x8, PC[g]), o[d], 0, 0, 0); } while (0)
#define ATT_ITER(i, PC, PN, HASPV) do { const bool dma = ((i) + 2 < ntile); if (dma && !(HASPV)) ATT_DMA((i) + 2); \
            ATT_SG(i); bf16x8 va[4], vb[4]; float lsa_ = 0.f, lsb_ = 0.f; \
            __builtin_amdgcn_s_setprio(1); \
            ATT_KLD(va, 0, i); ATT_KLD(vb, 1, i); ATT_SB(); ATT_KMM(va, 0); ATT_SB(); if (HASPV) { ATT_VLD(va, 0, i); ATT_SB(); } ATT_KMM(vb, 1); ATT_SB(); \
            __builtin_amdgcn_s_setprio(0); \
            ATT_MIDBIAS(i); ATT_SB(); \
            _Pragma("unroll") for (int g = 0; g < 4; ++g) { \
                _Pragma("unroll") for (int d = 0; d < 4; ++d) { if (HASPV) { o[d] = __builtin_amdgcn_mfma_f32_32x32x16_bf16(va[d], __builtin_bit_cast(bf16x8, PC[g]), o[d], 0, 0, 0); \
                          \
                        if (d >= 1 && g < 3) { const int dd_ = 32 * (d - 1) + r32; va[d - 1] = *(const LAS bf16x8*)(lds + (((i) - 1) & 3) * 32768 + 16384 + dd_ * 128 + (((2 * (g + 1) + hi) ^ ((dd_ >> 1) & 7)) << 4)); } \
                        if (d == 0 && g >= 1) { const int dd_ = 32 * 3 + r32; va[3] = *(const LAS bf16x8*)(lds + (((i) - 1) & 3) * 32768 + 16384 + dd_ * 128 + (((2 * g + hi) ^ ((dd_ >> 1) & 7)) << 4)); } } \
                    ATT_SLICE(PN, 4 * g + d); ATT_SB(); } \
                if ((HASPV) && dma) { const unsigned sl_ = lds0 + (unsigned)((((i) + 2) & 3) * 32768);     \
                    if (g & 1) glds16(vg0 + (size_t)((i) + 2) * 8192, (unsigned)voff[g >> 1], (unsigned)__builtin_amdgcn_readfirstlane(sl_ + vdst[g >> 1])); \
                    else glds16(kg0 + (size_t)((i) + 2) * 64 * PROJ_N, (unsigned)koff[g >> 1], (unsigned)__builtin_amdgcn_readfirstlane(sl_ + kdst[g >> 1])); } } \
            ATT_FINAL(); ATT_BAR(dma); } while (0)
#define ATT_DRAIN(PC) do { bf16x8 va[4]; \
            _Pragma("unroll") for (int g = 0; g < 4; ++g) { ATT_VLD(va, g, ntile); ATT_SB(); ATT_PVG(PC, g); ATT_SB(); } \
            } while (0)
        u32x4 pA[4], pB[4];
        ATT_DMA(0); if (ntile > 1) ATT_DMA(1);
        ATT_WAIT_BAR();
        ATT_ITER(0, pB, pA, false);
        for (int i = 1; i < ntile; i += 2) {
            ATT_ITER(i, pA, pB, true);
            if (i + 1 < ntile) ATT_ITER(i + 1, pB, pA, true);
        }
        if ((ntile - 1) & 1) ATT_DRAIN(pB); else ATT_DRAIN(pA);
#undef ATT_SB
#undef ATT_KLD
#undef ATT_KMM
#undef ATT_SG
#undef ATT_VLD
#undef ATT_BAR
#undef ATT_SLICE
#undef ATT_MIDBIAS
#undef ATT_FINAL
#undef ATT_ITER
#undef ATT_DRAIN
#undef ATT_PVG
        __syncthreads();
#undef ATT_DMA
        lsum += __shfl_xor(lsum, 32);
        const float lam = atab[128];
        const float inv = (s == 0 ? 1.0f : lam) / lsum;
        LAS float* cb = (LAS float*)lds + g * 4096;
        if (s == 1) {
#pragma unroll
            for (int d = 0; d < 4; ++d)
#pragma unroll
                for (int r = 0; r < 16; ++r) cb[(d * 16 + r) * 64 + lane] = o[d][r] * inv;
        }
        __syncthreads();
        if (s == 0) {
            float ss = 0.f;
#pragma unroll
            for (int d = 0; d < 4; ++d) {
#pragma unroll
                for (int r = 0; r < 16; ++r) { const float v = o[d][r] * inv - cb[(d * 16 + r) * 64 + lane]; o[d][r] = v; ss += v * v; }
                __builtin_amdgcn_sched_barrier(0); }
            ss += __shfl_xor(ss, 32);
            const float rs = rsqrtf(ss * (1.0f / 128.0f) + LN_EPS) * (1.0f - LAMBDA_INIT);
            const LAS float* sw = atab;
            bf16_t* orow = mix + (size_t)(b * SEQ + q0 + 32 * g + r32) * DM + h * 128;
#pragma unroll
            for (int d = 0; d < 4; ++d) {
                u32x2 w[4];
#pragma unroll
                for (int rq = 0; rq < 4; ++rq) { const int dcol = 32 * d + 8 * rq + 4 * hi; const f32x4 wv = *(const LAS f32x4*)(sw + dcol);
                    w[rq].x = cvt_pk_bf16_c(o[d][4 * rq + 0] * rs * wv[0], o[d][4 * rq + 1] * rs * wv[1]); w[rq].y = cvt_pk_bf16_c(o[d][4 * rq + 2] * rs * wv[2], o[d][4 * rq + 3] * rs * wv[3]); }
#pragma unroll
                for (int rp = 0; rp < 2; ++rp) { const auto sx = __builtin_amdgcn_permlane32_swap(w[2 * rp].x, w[2 * rp + 1].x, false, false), sy = __builtin_amdgcn_permlane32_swap(w[2 * rp].y, w[2 * rp + 1].y, false, false);
                    u32x4 q4; q4.x = sx[0]; q4.y = sy[0]; q4.z = sx[1]; q4.w = sy[1];
                    *(u32x4*)(orow + 32 * d + 8 * (2 * rp + hi)) = q4; }
                __builtin_amdgcn_sched_barrier(0); }
        }
        if (F.tid == 0) { int nx = -1; if (qk < 8) { if (tkt < 256u) nx = ((myq + qk) & 7) * 256 + (int)tkt; else { ++qk; nx = att_take(aq, myq, qk); } } qslot[0] = nx; }
    }
    __syncthreads();
    unit = qslot[0];
    if (ndone++ == 0) after_first();
    }
    if (ndone == 0) after_first();
}

__device__ __forceinline__ void ln_rows(Frame& F, const bf16_t* z, const float* gam, const float* bet, unsigned char* oq, float* stats, int wg0) {
    const int gw = (F.vcu - wg0) * NWAVES + F.wave, NGW = (F.G - wg0) * NWAVES, lane = F.lane;
    for (int m = gw; m < NTOK; m += NGW) {
        const GAS u32x4* zr = (const GAS u32x4*)(z + (size_t)m * DM) + lane;
        f32x4 v[8]; float s = 0.f;
#pragma unroll
        for (int j = 0; j < 4; ++j) { const u32x4 r = zr[64 * j]; v[2 * j] = f32x4{bflo(r.x), bfhi(r.x), bflo(r.y), bfhi(r.y)}; v[2 * j + 1] = f32x4{bflo(r.z), bfhi(r.z), bflo(r.w), bfhi(r.w)};
            s += ((v[2 * j].x + v[2 * j].y) + (v[2 * j].z + v[2 * j].w)) + ((v[2 * j + 1].x + v[2 * j + 1].y) + (v[2 * j + 1].z + v[2 * j + 1].w)); }
        const float mean = wave_sum(s) * (1.f / DM); float s2 = 0.f;
#pragma unroll
        for (int j = 0; j < 8; ++j) { v[j] = v[j] - mean; s2 += (v[j].x * v[j].x + v[j].y * v[j].y) + (v[j].z * v[j].z + v[j].w * v[j].w); }
        const float rstd = rsqrtf(wave_sum(s2) * (1.f / DM) + LN_EPS);
        if (lane == 0) { stats[2 * m] = mean; stats[2 * m + 1] = rstd; }
        GAS u32x2* o8 = (GAS u32x2*)(oq + (size_t)m * DM) + lane;
#pragma unroll
        for (int j = 0; j < 4; ++j) { const f32x4 g0 = *((const f32x4*)gam + 2 * (lane + 64 * j)), g1 = *((const f32x4*)gam + 2 * (lane + 64 * j) + 1), b0 = *((const f32x4*)bet + 2 * (lane + 64 * j)), b1 = *((const f32x4*)bet + 2 * (lane + 64 * j) + 1);
            const f32x4 y0 = v[2 * j] * rstd * g0 + b0, y1 = v[2 * j + 1] * rstd * g1 + b1;
            int p0 = __builtin_amdgcn_cvt_pk_fp8_f32(y0.x, y0.y, 0, false); p0 = __builtin_amdgcn_cvt_pk_fp8_f32(y0.z, y0.w, p0, true);
            int p1 = __builtin_amdgcn_cvt_pk_fp8_f32(y1.x, y1.y, 0, false); p1 = __builtin_amdgcn_cvt_pk_fp8_f32(y1.z, y1.w, p1, true);
            u32x2 w; w.x = (unsigned)p0; w.y = (unsigned)p1; o8[64 * j] = w; }
    }
}

struct ProbMV {
    static constexpr bool META = false, GATHER = false, FP8 = true;
    int Kb, lda, ldb, G, c;
    const unsigned char *kmem, *vmem, *wqn, *wo8;
    __device__ __forceinline__ bool next(int i, pg8::Unit& u) const { const int L = i * G + c; if (L >= 256) return false; u.g = L >> 7; u.pm = (L >> 3) & 15; u.pn = L & 7; return true; }
    __device__ __forceinline__ const char* a_base(const pg8::Unit& u) const { return (const char*)(u.g == 0 ? kmem + (size_t)((u.pm >> 2) * NMEM) * DM + (u.pm & 3) * MHD : wo8 + (size_t)(u.pn * 256) * DM + (u.pm & 3) * MHD); }
    __device__ __forceinline__ const char* b_base(const pg8::Unit& u) const { return (const char*)(u.g == 0 ? wqn + (size_t)(u.pn * 256) * DM + (u.pm & 3) * MHD : vmem + (size_t)((u.pm >> 2) * NMEM) * DM + (u.pm & 3) * MHD); }
};
struct EpiMV {
    static constexpr bool PERM = true;
    unsigned char *MT, *VWT;
    __device__ __forceinline__ void operator()(const pg8::Acc& acc, const pg8::Unit& u, int wr, int wc, int fr, int fq) const {
        if (u.g == 0) pg8::store_tile_fp8(acc, MT + (size_t)((u.pm >> 2) * 1024 + (u.pm & 3) * 256) * DM + u.pn * 256, DM, 1.0f / M8_DIV, wr, wc, fr, fq);
        else pg8::store_tile_fp8(acc, VWT + (size_t)((u.pm >> 2) * DM + u.pn * 256) * 1024 + (u.pm & 3) * 256, 1024, 1.0f / VW8_DIV, wr, wc, fr, fq); }
};
struct ProbScores {
    static constexpr bool META = false, GATHER = false, FP8 = true;
    int Kb, lda, ldb, G, c;
    const unsigned char *x1q, *MT;
    __device__ __forceinline__ bool next(int i, pg8::Unit& u) const { const int L = i * G + c; if (L >= 512) return false; const int w = pg8::xcd_chunk(L, 512); u.g = w >> 5; u.pm = w & 31; u.pn = 0; return true; }
    __device__ __forceinline__ const char* a_base(const pg8::Unit& u) const { return (const char*)(x1q + (size_t)((u.g >> 2) * SEQ + u.pm * 256) * DM); }
    __device__ __forceinline__ const char* b_base(const pg8::Unit& u) const { return (const char*)(MT + (size_t)((u.g >> 2) * 1024 + (u.g & 3) * 256) * DM); }
};
struct EpiSoftmax {
    static constexpr bool PERM = true;
    unsigned char* Pm; LAS float* PM; LAS float* PS;
    __device__ __forceinline__ void operator()(pg8::Acc& acc, const pg8::Unit& u, int wr, int wc, int fr_, int fq) const {
        const int fr = opaque(fr_);
        constexpr float SSCALE = MQSCALE * M8_DIV / WQ8_SCALE;
#pragma unroll
        for (int ai = 0; ai < 2; ++ai)
#pragma unroll
            for (int m = 0; m < 4; ++m) { float x = -INFINITY;
#pragma unroll
                for (int bj = 0; bj < 2; ++bj)
#pragma unroll
                    for (int n = 0; n < 2; ++n) { const f32x4 v = acc[ai][bj][m][n] * SSCALE; acc[ai][bj][m][n] = v; x = fmaxf(fmaxf(x, fmaxf(v[0], v[1])), fmaxf(v[2], v[3])); }
                x = fmaxf(x, __shfl_xor(x, 16)); x = fmaxf(x, __shfl_xor(x, 32));
                if (fq == 0) PM[(ai * 128 + wr * 64 + m * 16 + fr) * 4 + wc] = x; }
        asm volatile("s_waitcnt lgkmcnt(0)" ::: "memory"); __builtin_amdgcn_s_barrier(); asm volatile("" ::: "memory");
#pragma unroll
        for (int ai = 0; ai < 2; ++ai)
#pragma unroll
            for (int m = 0; m < 4; ++m) { const f32x4 q = *(const LAS f32x4*)(PM + (ai * 128 + wr * 64 + m * 16 + fr) * 4); const float mxr = fmaxf(fmaxf(q[0], q[1]), fmaxf(q[2], q[3])); float sm = 0.f;
#pragma unroll
                for (int bj = 0; bj < 2; ++bj)
#pragma unroll
                    for (int n = 0; n < 2; ++n) { f32x4 v = acc[ai][bj][m][n];
#pragma unroll
                        for (int e = 0; e < 4; ++e) { v[e] = __builtin_amdgcn_exp2f(v[e] - mxr); sm += v[e]; }
                        acc[ai][bj][m][n] = v; }
                sm += __shfl_xor(sm, 16); sm += __shfl_xor(sm, 32);
                if (fq == 0) PS[(ai * 128 + wr * 64 + m * 16 + fr) * 4 + wc] = sm; }
        asm volatile("s_waitcnt lgkmcnt(0)" ::: "memory"); __builtin_amdgcn_s_barrier(); asm volatile("" ::: "memory");
        unsigned char* O = Pm + (size_t)((u.g >> 2) * SEQ + u.pm * 256) * 1024 + (u.g & 3) * 256;
#pragma unroll
        for (int ai = 0; ai < 2; ++ai)
#pragma unroll
            for (int m = 0; m < 4; ++m) { const f32x4 q = *(const LAS f32x4*)(PS + (ai * 128 + wr * 64 + m * 16 + fr) * 4); const float inv = P8_SCALE / ((q[0] + q[1]) + (q[2] + q[3]));
                unsigned char* rowp = O + (size_t)(ai * 128 + wr * 64 + m * 16 + fr) * 1024 + wc * 32 + ((fq & 1) ? 128 + 8 * (fq - 1) : 8 * fq);
                *(u32x4*)rowp = pg8::pair16(pg8::pack8_fp8(acc[ai][0][m][0] * inv, acc[ai][0][m][1] * inv), pg8::pack8_fp8(acc[ai][1][m][0] * inv, acc[ai][1][m][1] * inv)); }
    }
};
struct ProbOutQ {
    static constexpr bool META = false, GATHER = false, FP8 = true;
    int Kb, lda, ldb, G, c;
    const unsigned char *P8, *VWT;
    __device__ __forceinline__ bool next(int i, pg8::Unit& u) const { const int L = i * G + c; if (L >= 1024) return false; u.g = 0; pg8::tile_of(pg8::xcd_chunk(L, 1024), 128, 8, 8, u.pm, u.pn); return true; }
    __device__ __forceinline__ const char* a_base(const pg8::Unit& u) const { return (const char*)(P8 + (size_t)u.pm * 256 * 1024); }
    __device__ __forceinline__ const char* b_base(const pg8::Unit& u) const { return (const char*)(VWT + (size_t)((u.pm >> 5) * DM + u.pn * 256) * 1024); }
};

__device__ __forceinline__ void p_ln2_router(Frame& F) {
    const bf16_t* z2 = (const bf16_t*)(F.ws + WS_Z); const bf16_t* rt = (const bf16_t*)(F.ws + WS_ROUTT);
    const float* gam = F.in[I_LN2G]; const float* bet = F.in[I_LN2B]; float* stats = (float*)(F.ws + WS_STAT2); unsigned char* xq = F.ws + WS_R1;
    int* eltok = (int*)(F.ws + WS_ELTOK); float* elgate = (float*)(F.ws + WS_ELGATE); int* tokslot = (int*)(F.ws + WS_TOKSLOT);
    LAS float* lg = (LAS float*)(F.lds) + F.wave * 512;
    LAS float* st = (LAS float*)(F.lds + 16384) + F.wave * 32;
    LAS int* lcnt = (LAS int*)(F.lds + XTRA_OFF);
    const int lane = F.lane, r16 = lane & 15, kq = lane >> 4;
    for (int blk = F.vcu; blk < NTOK / 128; blk += F.G) {
        __syncthreads();
        if (F.tid < 64) lcnt[F.tid] = 0;
        __syncthreads();
        const int tok0 = blk * 128 + F.wave * 16;
        for (int j = 0; j < 16; ++j) { const int m = tok0 + j;
            const GAS u32x4* zr = (const GAS u32x4*)(z2 + (size_t)m * DM) + lane;
            f32x4 v[8]; float s = 0.f;
#pragma unroll
            for (int q = 0; q < 4; ++q) { const u32x4 r = zr[64 * q]; v[2 * q] = f32x4{bflo(r.x), bfhi(r.x), bflo(r.y), bfhi(r.y)}; v[2 * q + 1] = f32x4{bflo(r.z), bfhi(r.z), bflo(r.w), bfhi(r.w)};
                s += ((v[2 * q].x + v[2 * q].y) + (v[2 * q].z + v[2 * q].w)) + ((v[2 * q + 1].x + v[2 * q + 1].y) + (v[2 * q + 1].z + v[2 * q + 1].w)); }
            const float mean = wave_sum(s) * (1.f / DM); float s2 = 0.f;
#pragma unroll
            for (int q = 0; q < 8; ++q) { v[q] = v[q] - mean; s2 += (v[q].x * v[q].x + v[q].y * v[q].y) + (v[q].z * v[q].z + v[q].w * v[q].w); }
            const float rstd = rsqrtf(wave_sum(s2) * (1.f / DM) + LN_EPS);
            if (lane == 0) { stats[2 * m] = mean; stats[2 * m + 1] = rstd; st[2 * j] = mean; st[2 * j + 1] = rstd; }
            GAS u32x2* o8 = (GAS u32x2*)(xq + (size_t)m * DM) + lane;
#pragma unroll
            for (int q = 0; q < 4; ++q) { const f32x4 g0 = *((const f32x4*)gam + 2 * (lane + 64 * q)), g1 = *((const f32x4*)gam + 2 * (lane + 64 * q) + 1), b0 = *((const f32x4*)bet + 2 * (lane + 64 * q)), b1 = *((const f32x4*)bet + 2 * (lane + 64 * q) + 1);
                const f32x4 y0 = v[2 * q] * rstd * g0 + b0, y1 = v[2 * q + 1] * rstd * g1 + b1;
                int p0 = __builtin_amdgcn_cvt_pk_fp8_f32(y0.x, y0.y, 0, false); p0 = __builtin_amdgcn_cvt_pk_fp8_f32(y0.z, y0.w, p0, true);
                int p1 = __builtin_amdgcn_cvt_pk_fp8_f32(y1.x, y1.y, 0, false); p1 = __builtin_amdgcn_cvt_pk_fp8_f32(y1.z, y1.w, p1, true);
                u32x2 w; w.x = (unsigned)p0; w.y = (unsigned)p1; o8[64 * q] = w; }
        }
        LDS_WAIT(); asm volatile("" ::: "memory");
        f32x4 a0 = {0.f, 0.f, 0.f, 0.f}, a1 = a0;
        {
            const bf16_t* xr = z2 + (size_t)(tok0 + r16) * DM + 8 * kq; const bf16_t* w0 = rt + (size_t)r16 * DM + 8 * kq; const bf16_t* w1 = rt + (size_t)(r16 + 16) * DM + 8 * kq;
            constexpr int LO = 32 * 2048;
            u32x4 zb[4], wa[4][2], wb[4][2];
#pragma unroll
            for (int u = 0; u < 4; ++u) { zb[u] = *(const u32x4*)(xr + 32 * u); wa[u][0] = *(const u32x4*)(w0 + 32 * u); wa[u][1] = *(const u32x4*)(w0 + LO + 32 * u); wb[u][0] = *(const u32x4*)(w1 + 32 * u); wb[u][1] = *(const u32x4*)(w1 + LO + 32 * u); }
#pragma unroll 1
            for (int j0 = 0; j0 < DM / 32; j0 += 4) {
#pragma unroll
                for (int u = 0; u < 4; ++u) {
                    const bf16x8 zz = __builtin_bit_cast(bf16x8, zb[u]), ah = __builtin_bit_cast(bf16x8, wa[u][0]), al = __builtin_bit_cast(bf16x8, wa[u][1]), bh = __builtin_bit_cast(bf16x8, wb[u][0]), bl = __builtin_bit_cast(bf16x8, wb[u][1]);
                    const int jn = (j0 + u + 4 < DM / 32) ? j0 + u + 4 : DM / 32 - 1;
                    zb[u] = *(const u32x4*)(xr + 32 * jn); wa[u][0] = *(const u32x4*)(w0 + 32 * jn); wa[u][1] = *(const u32x4*)(w0 + LO + 32 * jn); wb[u][0] = *(const u32x4*)(w1 + 32 * jn); wb[u][1] = *(const u32x4*)(w1 + LO + 32 * jn);
                    __builtin_amdgcn_sched_barrier(0);
                    a0 = __builtin_amdgcn_mfma_f32_16x16x32_bf16(zz, ah, a0, 0, 0, 0); a1 = __builtin_amdgcn_mfma_f32_16x16x32_bf16(zz, bh, a1, 0, 0, 0);
                    a0 = __builtin_amdgcn_mfma_f32_16x16x32_bf16(zz, al, a0, 0, 0, 0); a1 = __builtin_amdgcn_mfma_f32_16x16x32_bf16(zz, bl, a1, 0, 0, 0);
                    __builtin_amdgcn_sched_barrier(0);
                }
            }
        }
        { const float* rc = (const float*)(F.ctl) + CW_RC; const float c1a = rc[r16], c1b = rc[16 + r16], c2a = rc[32 + r16], c2b = rc[48 + r16];
#pragma unroll
          for (int j = 0; j < 4; ++j) { const float mu = st[2 * (4 * kq + j)], rs = st[2 * (4 * kq + j) + 1];
              lg[(4 * kq + j) * 32 + r16] = (a0[j] - mu * c1a) * rs + c2a; lg[(4 * kq + j) * 32 + 16 + r16] = (a1[j] - mu * c1b) * rs + c2b; } }
        LDS_WAIT(); asm volatile("" ::: "memory");
        int es[4], rk[4]; float gs[4];
        if (lane < 16) {
            float v[32];
#pragma unroll
            for (int e = 0; e < 32; ++e) v[e] = lg[lane * 32 + e];
            float tv[4];
#pragma unroll
            for (int k = 0; k < 4; ++k) { float best = -INFINITY; int bi = 0;
#pragma unroll
                for (int e = 0; e < 32; ++e) { if (v[e] > best) { best = v[e]; bi = e; } }
                tv[k] = best; es[k] = bi;
#pragma unroll
                for (int e = 0; e < 32; ++e) if (e == bi) v[e] = -INFINITY; }
            const float e1 = __expf(tv[1] - tv[0]), e2 = __expf(tv[2] - tv[0]), e3 = __expf(tv[3] - tv[0]); const float inv = 1.0f / (1.0f + e1 + e2 + e3);
            gs[0] = inv; gs[1] = e1 * inv; gs[2] = e2 * inv; gs[3] = e3 * inv;
#pragma unroll
            for (int k = 0; k < 4; ++k) rk[k] = __hip_atomic_fetch_add(&lcnt[es[k]], 1, __ATOMIC_RELAXED, __HIP_MEMORY_SCOPE_WORKGROUP);
        }
        __syncthreads();
        if (F.tid < 32) lcnt[32 + F.tid] = (int)__hip_atomic_fetch_add((unsigned*)(F.ctl + CW_ECNT) + F.tid, (unsigned)lcnt[F.tid], RLX_AGENT);
        __syncthreads();
        if (lane < 16) { const int tok = tok0 + lane;
#pragma unroll
            for (int k = 0; k < 4; ++k) { const int pos = lcnt[32 + es[k]] + rk[k]; eltok[es[k] * NTOK + pos] = tok; elgate[es[k] * NTOK + pos] = gs[k]; tokslot[tok * 4 + k] = (es[k] << 16) | pos; } }
    }
    __syncthreads();
}

struct ESched { LAS int* tb; };
__device__ __forceinline__ void build_esched(Frame& F, LAS int* tb, int nN) {
    __syncthreads();
    if (F.tid < 64) { const int e = F.lane & 31; const int c = (int)__hip_atomic_load((unsigned*)(F.ctl + CW_ECNT) + e, RLX_AGENT);
        int rs = 0, us = 0, uc = 0;
        for (int j = 0; j < 32; ++j) { const int cj = __shfl(c, j); if (j < e) { rs += (cj + 31) & ~31; us += ((cj + 127) >> 8) * nN; uc += (((cj + 255) >> 8) - ((cj + 127) >> 8)) * nN; } }
        if (F.lane < 32) { tb[e] = c; tb[32 + e] = rs; tb[65 + e] = us; tb[98 + e] = uc; if (e == 31) { tb[64] = rs + ((c + 31) & ~31); tb[97] = us + ((c + 127) >> 8) * nN; tb[130] = uc + (((c + 255) >> 8) - ((c + 127) >> 8)) * nN; } } }
    __syncthreads();
}
template <int NN, bool GATH> struct ProbExpert {
    static constexpr bool META = true, GATHER = GATH, FP8 = true;
    int Kb, lda, ldb, G, c;
    LAS int* tb; const unsigned char* A; const unsigned char* W; size_t wstride;
    const void* listA;
    const float* b0; const float* b1;
    LAS unsigned char* meta;
    __device__ __forceinline__ int rd(int i) const { return __builtin_amdgcn_readfirstlane(tb[i]); }
    __device__ __forceinline__ bool next(int i, pg8::Unit& u) const {
        if (i >= 128) return false;
        const LAS int* p = tb + 256 + i * 8; const v4i32 a = *(const LAS v4i32*)p; const int r4 = p[4], r5 = p[5];
        u.g = __builtin_amdgcn_readfirstlane(a[0]); u.pm = __builtin_amdgcn_readfirstlane(a[1]); u.pn = __builtin_amdgcn_readfirstlane(a[2]); u.rs = __builtin_amdgcn_readfirstlane(r4); u.cnt = __builtin_amdgcn_readfirstlane(r5);
        return u.g >= 0; }
    __device__ __forceinline__ void table_entry(int i, LAS int* ent) const {
        const int L = i * G + c, nfull = tb[97]; int e = -1, pm = 0, pn = 0;
        if (L < nfull + tb[130]) {
            const bool shrt = L >= nfull; const int w = shrt ? L - nfull : pg8::xcd_chunk(L, nfull), t0 = shrt ? 98 : 65;
            e = 0;
#pragma unroll
            for (int st = 16; st >= 1; st >>= 1) if (tb[t0 + e + st] <= w) e += st;
            const int loc = w - tb[t0 + e], nF = (tb[e] + 127) >> 8;
            if (shrt) { pm = nF; pn = loc; } else pg8::tile_of(loc, nF, NN, NN == 16 ? 8 : 4, pm, pn); }
        const int cn = e >= 0 ? tb[e] : 0;
        ent[0] = e; ent[1] = pm; ent[2] = pn; ent[3] = (cn - pm * 256 <= 128) ? 1 : 0; ent[4] = e >= 0 ? tb[32 + e] : 0; ent[5] = cn; ent[6] = 0; ent[7] = 0; }
    __device__ __forceinline__ bool lower_only(const pg8::Unit& u) const { return u.cnt - u.pm * 256 <= 128; }
    __device__ __forceinline__ const char* a_base(const pg8::Unit& u) const { if constexpr (GATH) return (const char*)A; else return (const char*)(A + (size_t)(u.rs + u.pm * 256) * lda); }
    __device__ __forceinline__ const char* b_base(const pg8::Unit& u) const { return (const char*)(W + (size_t)u.g * wstride + (size_t)u.pn * 256 * ldb); }
    __device__ __forceinline__ void meta_prefetch(const pg8::Unit& u, int slot, int wid, int lane) const {
        if (wid == 0) { const unsigned dst = (unsigned)(size_t)(meta + slot * 2048);
            glds16v((const char*)listA + ((size_t)u.g * NTOK + (size_t)u.pm * 256) * 4 + lane * 16, dst);
            const float* src; if constexpr (GATH) src = (lane < 32 ? b0 : b1) + (size_t)u.g * FF + u.pn * 128 + (lane & 31) * 4; else src = b0 + (size_t)u.g * DM + u.pn * 256 + lane * 4;
            glds16v(src, dst + 1024u); }
    }
    __device__ __forceinline__ void a_rows(const pg8::Unit& u, int slot, const int (&Rl)[2], const int (&Cl)[2], unsigned (&voff)[2][2]) const {
        const int cnt = u.cnt; const LAS int* idx = (const LAS int*)(meta + slot * 2048);
#pragma unroll
        for (int h = 0; h < 2; ++h)
#pragma unroll
            for (int i = 0; i < 2; ++i) { const int r = h * 128 + Rl[i]; const int tok = (u.pm * 256 + r < cnt) ? idx[r] : 0;
                voff[h][i] = (unsigned)tok * (unsigned)lda + (unsigned)Cl[i] * 2u; }
    }
};
namespace pg8 { template <> struct a_blocked<ProbExpert<8, false>> { static constexpr bool value = true; }; }
struct EpiSwiGLU {
    static constexpr bool PERM = true;
    LAS int* tb; unsigned char* H; LAS unsigned char* meta;
    __device__ __forceinline__ u32x2 row8(const pg8::Acc& acc, int ai, int m, const f32x4& g0, const f32x4& g1, const f32x4& u0, const f32x4& u1) const {
        constexpr float CG = SW_ALPHA * LOG2E;
        f32x4 ga = acc[ai][0][m][0] * (CG / WG_SCALE) + g0, gb = acc[ai][0][m][1] * (CG / WG_SCALE) + g1, ua = acc[ai][1][m][0] * (1.0f / (CG * WG_SCALE)) + u0, ub = acc[ai][1][m][1] * (1.0f / (CG * WG_SCALE)) + u1; f32x4 h0, h1;
#pragma unroll
        for (int j = 0; j < 4; ++j) { const float gg = fminf(ga[j], CG * SW_LIMIT), uu = __builtin_amdgcn_fmed3f(ua[j], (1.0f - SW_LIMIT) / CG, (1.0f + SW_LIMIT) / CG); h0[j] = gg * __builtin_amdgcn_rcpf(1.0f + __builtin_amdgcn_exp2f(-gg)) * uu;
            const float g2 = fminf(gb[j], CG * SW_LIMIT), u2 = __builtin_amdgcn_fmed3f(ub[j], (1.0f - SW_LIMIT) / CG, (1.0f + SW_LIMIT) / CG); h1[j] = g2 * __builtin_amdgcn_rcpf(1.0f + __builtin_amdgcn_exp2f(-g2)) * u2; }
        return pg8::pack8_fp8(h0, h1); }
    __device__ __forceinline__ void operator()(const pg8::Acc& acc, const pg8::Unit& u, int wr, int wc, int fr_, int fq, int slot) const {
        const int fr = opaque(fr_);
        const int cnt = u.cnt, rs = u.rs;
        const int cpart = u.pn * 4096 + wc * 1024 + (fq >> 1) * 16;
        const LAS float* mb = (const LAS float*)(meta + slot * 2048 + 1024) + wc * 32 + 8 * fq;
        constexpr float CGb = SW_ALPHA * LOG2E;
        const f32x4 g0 = *(const LAS f32x4*)(mb) * CGb, g1 = *(const LAS f32x4*)(mb + 4) * CGb, u0 = (*(const LAS f32x4*)(mb + 128) + 1.0f) * (1.0f / CGb), u1 = (*(const LAS f32x4*)(mb + 132) + 1.0f) * (1.0f / CGb);
#pragma unroll
        for (int ai = 0; ai < 2; ++ai)
#pragma unroll
            for (int m = 0; m < 4; m += 2) { const int r = u.pm * 256 + ai * 128 + wr * 64 + (m + (fq & 1)) * 16 + fr;
                const u32x4 q = pg8::pair16(row8(acc, ai, m, g0, g1, u0, u1), row8(acc, ai, m + 1, g0, g1, u0, u1));
                if (r < cnt) *(u32x4*)(H + (size_t)(rs + (r & ~31)) * FF + cpart + (r & 31) * 32) = q; }
    }
};
struct EpiDown {
    static constexpr bool PERM = true;
    LAS int* tb; unsigned char* Y; LAS unsigned char* meta;
    __device__ __forceinline__ void operator()(const pg8::Acc& acc, const pg8::Unit& u, int wr, int wc, int fr_, int fq, int slot) const {
        const int fr = opaque(fr_);
        const int cnt = u.cnt, rs = u.rs;
        const int col = u.pn * 256 + wc * 64 + ((fq & 1) ? 32 + 8 * (fq - 1) : 8 * fq);
        f32x4 bv[2][2];
#pragma unroll
        for (int bj = 0; bj < 2; ++bj)
#pragma unroll
            for (int n = 0; n < 2; ++n) bv[bj][n] = *(const LAS f32x4*)((const LAS float*)(meta + slot * 2048 + 1024) + wc * 32 + 8 * fq + bj * 128 + 4 * n);
        float gtv[2][4];
#pragma unroll
        for (int ai = 0; ai < 2; ++ai)
#pragma unroll
            for (int m = 0; m < 4; ++m) gtv[ai][m] = ((const LAS float*)(meta + slot * 2048))[ai * 128 + wr * 64 + m * 16 + fr];
#pragma unroll
        for (int ai = 0; ai < 2; ++ai)
#pragma unroll
            for (int m = 0; m < 4; ++m) { const int r = u.pm * 256 + ai * 128 + wr * 64 + m * 16 + fr; const bool ok = r < cnt; const float gt = gtv[ai][m];
                unsigned char* rowp = Y + (size_t)(rs + r) * DM + col; const float gy = gt * Y_SCALE;
                const u32x4 q = pg8::pair16(pg8::pack8_fp8((acc[ai][0][m][0] * (1.0f / WD_SCALE) + bv[0][0]) * gy, (acc[ai][0][m][1] * (1.0f / WD_SCALE) + bv[0][1]) * gy),
                                            pg8::pack8_fp8((acc[ai][1][m][0] * (1.0f / WD_SCALE) + bv[1][0]) * gy, (acc[ai][1][m][1] * (1.0f / WD_SCALE) + bv[1][1]) * gy));
                if (ok) *(u32x4*)rowp = q; }
    }
};

__device__ __forceinline__ void p_final(Frame& F, LAS int* tb) {
    const int gw = F.vcu * NWAVES + F.wave, NGW = F.G * NWAVES, lane = F.lane;
    const unsigned char* Y = (const unsigned char*)(F.ws + WS_Y); const int* tokslot = (const int*)(F.ws + WS_TOKSLOT);
    const float* gam = F.in[I_LN3G]; const float* bet = F.in[I_LN3B]; const bf16_t* z = (const bf16_t*)(F.ws + WS_Z); float* out = F.out;
    const float* g2 = F.in[I_LN2G]; const float* b2 = F.in[I_LN2B]; const float* stats = (const float*)(F.ws + WS_STAT2);
    for (int m = gw; m < NTOK; m += NGW) {
        const float mu2 = stats[2 * m], rs2 = stats[2 * m + 1];
        int slot[4];
#pragma unroll
        for (int k = 0; k < 4; ++k) { const int ts = tokslot[m * 4 + k]; slot[k] = tb[32 + (ts >> 16)] + (ts & 0xffff); }
        const GAS u32x4* zr = (const GAS u32x4*)(z + (size_t)m * DM) + lane;
        f32x4 v[8]; float s = 0.f;
#pragma unroll
        for (int j = 0; j < 4; ++j) { const u32x4 r = zr[64 * j]; const int c4 = 2 * (lane + 64 * j);
            f32x4 a0 = (((f32x4{bflo(r.x), bfhi(r.x), bflo(r.y), bfhi(r.y)} - mu2) * rs2) * *((const f32x4*)g2 + c4) + *((const f32x4*)b2 + c4)) * ALPHA;
            f32x4 a1 = (((f32x4{bflo(r.z), bfhi(r.z), bflo(r.w), bfhi(r.w)} - mu2) * rs2) * *((const f32x4*)g2 + c4 + 1) + *((const f32x4*)b2 + c4 + 1)) * ALPHA;
            const int yc = (lane + 64 * j) * 8, yoff = (yc & ~255) + ((yc >> 5) & 3) * 64 + ((yc >> 7) & 1) * 32 + (yc & 31);
#pragma unroll
            for (int k = 0; k < 4; ++k) { const u32x2 w = *(const GAS u32x2*)(Y + (size_t)slot[k] * DM + yoff);
                const auto l0 = __builtin_amdgcn_cvt_pk_f32_fp8((int)w.x, false), h0 = __builtin_amdgcn_cvt_pk_f32_fp8((int)w.x, true), l1 = __builtin_amdgcn_cvt_pk_f32_fp8((int)w.y, false), h1 = __builtin_amdgcn_cvt_pk_f32_fp8((int)w.y, true);
                a0[0] += l0[0] * (1.0f / Y_SCALE); a0[1] += l0[1] * (1.0f / Y_SCALE); a0[2] += h0[0] * (1.0f / Y_SCALE); a0[3] += h0[1] * (1.0f / Y_SCALE);
                a1[0] += l1[0] * (1.0f / Y_SCALE); a1[1] += l1[1] * (1.0f / Y_SCALE); a1[2] += h1[0] * (1.0f / Y_SCALE); a1[3] += h1[1] * (1.0f / Y_SCALE); }
            v[2 * j] = a0; v[2 * j + 1] = a1; s += ((a0.x + a0.y) + (a0.z + a0.w)) + ((a1.x + a1.y) + (a1.z + a1.w)); }
        const float mean = wave_sum(s) * (1.f / DM); float s2 = 0.f;
#pragma unroll
        for (int j = 0; j < 8; ++j) { v[j] = v[j] - mean; s2 += (v[j].x * v[j].x + v[j].y * v[j].y) + (v[j].z * v[j].z + v[j].w * v[j].w); }
        const float rstd = rsqrtf(wave_sum(s2) * (1.f / DM) + LN_EPS);
        GAS f32x4* orow = (GAS f32x4*)(out + (size_t)m * DM);
#pragma unroll
        for (int j = 0; j < 4; ++j) { const int c4 = 2 * (lane + 64 * j);
            v[2 * j] = v[2 * j] * rstd * *((const f32x4*)gam + c4) + *((const f32x4*)bet + c4); v[2 * j + 1] = v[2 * j + 1] * rstd * *((const f32x4*)gam + c4 + 1) + *((const f32x4*)bet + c4 + 1); }
#pragma unroll
        for (int j = 0; j < 4; ++j) { const int c4 = 2 * (lane + 64 * j); orow[c4] = v[2 * j]; orow[c4 + 1] = v[2 * j + 1]; }
    }
}

constexpr int NPHASE = 15;
struct Args { const float* in[27]; float* out; unsigned char* ws; int ph_lo, ph_hi; };
__global__ void __launch_bounds__(NWAVES * 64, 2) mk_fwd(Args args) {
    extern __shared__ __attribute__((aligned(16))) unsigned char lds_raw[];
    Frame F;
    F.lds = (LAS unsigned char*)lds_raw;
    F.tid = threadIdx.x; F.lane = F.tid & 63; F.wave = __builtin_amdgcn_readfirstlane(F.tid >> 6);
    F.G = gridDim.x; { const int bx = blockIdx.x; F.vcu = (F.G % 8 == 0) ? (bx % 8) * (F.G / 8) + bx / 8 : bx; }
    F.ws = args.ws; F.ctl = (gu32*)(args.ws + WS_CTL); F.out = args.out;
#pragma unroll
    for (int i = 0; i < 27; ++i) F.in[i] = args.in[i];
    volatile LAS unsigned* MISC = (volatile LAS unsigned*)(F.lds + MISC_OFF);
    for (int u = F.tid; u < (LDS_BYTES - MISC_OFF) / 4; u += NWAVES * 64) ((LAS unsigned*)(F.lds + MISC_OFF))[u] = 0u;
    __syncthreads();
    const int lo = args.ph_lo, hi = args.ph_hi;
    XcdBarrier bar; bar.bar = (unsigned*)(F.ctl + CW_BAR); bar.x = 0; bar.st = nullptr;
    if (hi - lo > 1) bar = xcd_barrier_post((unsigned*)(F.ctl + CW_BAR), MISC + 8);
#define IN(k) (lo <= (k) && (k) < hi)
#define SEAM(k) do { if (IN(k) && IN((k) + 1)) xcd_barrier(bar); } while (0)
    LAS int* tb = (LAS int*)(F.lds + XTRA_OFF + 8192);
    const int bx = (int)blockIdx.x;

#define REP(k) for (int rep_ = 0; rep_ < (((PROBE_MASK) >> (k)) & 1) + 1; ++rep_)
    if (IN(0)) { REP(0) p0_prologue(F); SEAM(0); }
    if (IN(1)) {
        ProbP1 P{4096, 4096, 4096, F.G, bx, (const bf16_t*)(F.ws + WS_R1), (const bf16_t*)(F.ws + WS_WINA), (const bf16_t*)(F.ws + WS_WINV), (const bf16_t*)(F.ws + WS_WKV), (const bf16_t*)(F.ws + WS_MEMB)};
        EpiP1 E{(bf16_t*)(F.ws + WS_PROJ), (bf16_t*)(F.ws + WS_VT), F.ws + WS_KMEM, F.ws + WS_VMEMT, F.ctl, (LAS float*)(F.lds + XTRA_OFF)};
        CONV_PRE(CONV_K0, CONV_K1);
        REP(1) pg8::gemm_phase<EpiP1, ProbP1, true>(F.lds, P, E);
        CONV_POST(CONV_K0, CONV_K1);
        SEAM(1);
    }
    if (IN(3)) { if (!(F.vcu & 1)) p2_conv<8>(F); CONV_PRE(CONV_K1, CONV_K3); p3_attention(F, [&]() { if (F.vcu & 1) { p2_conv<8>(F); __syncthreads(); p0_conv_range(F, CONV_K1, CONV_K3); __syncthreads(); } });
        SEAM(3); }
    if (IN(4)) {
        ProbDense P{4096, 4096, 4096, F.G, bx, 128, 8, (const bf16_t*)(F.ws + WS_MIX), (const bf16_t*)(F.ws + WS_WOUT)};
        EpiResB E{(const bf16_t*)(F.ws + WS_R1), (bf16_t*)(F.ws + WS_Z)};
        CONV_PRE(CONV_K3, CONV_K4);
        pg8::gemm_phase<EpiResB, ProbDense, true>(F.lds, P, E);
        CONV_POST(CONV_K3, CONV_K4);
        SEAM(4);
    }
    if (IN(5)) {
        if (F.vcu < 64) {
            ProbKV P{4096, 4096, 4096, F.vcu, (const bf16_t*)(F.ws + WS_WKV), (const bf16_t*)(F.ws + WS_MEMB)};
            EpiP1 E{(bf16_t*)(F.ws + WS_PROJ), (bf16_t*)(F.ws + WS_VT), F.ws + WS_KMEM, F.ws + WS_VMEMT, F.ctl, (LAS float*)(F.lds + XTRA_OFF)};
            pg8::gemm_phase<EpiP1, ProbKV, true>(F.lds, P, E);
        } else ln_rows(F, (const bf16_t*)(F.ws + WS_Z), F.in[I_LN1G], F.in[I_LN1B], F.ws + WS_R1, (float*)(F.ws + WS_STAT1), 64);
        SEAM(5);
    }
    if (IN(6)) {
        ProbMV P{512, 2048, 2048, F.G, bx, F.ws + WS_KMEM, F.ws + WS_VMEMT, F.ws + WS_WQ, F.ws + WS_WO};
        EpiMV E{F.ws + WS_MT, F.ws + WS_VWT};
        pg8::gemm_phase<EpiMV, ProbMV, true>(F.lds, P, E);
        SEAM(6);
    }
    if (IN(7)) {
        ProbScores P{2048, 2048, 2048, F.G, bx, F.ws + WS_R1, F.ws + WS_MT};
        EpiSoftmax E{F.ws + WS_P, (LAS float*)(F.lds + XTRA_OFF), (LAS float*)(F.lds + XTRA_OFF + 4096)};
        CONV_PRE(CONV_K4, CONV_K6);
        pg8::gemm_phase<EpiSoftmax, ProbScores, true>(F.lds, P, E);
        CONV_POST(CONV_K4, CONV_K6);
        SEAM(7);
    }
    if (IN(9)) {
        ProbOutQ P{1024, 1024, 1024, F.G, bx, F.ws + WS_P, F.ws + WS_VWT};
        EpiResLNB E{(const bf16_t*)(F.ws + WS_Z), (bf16_t*)(F.ws + WS_Z), (const float*)(F.ws + WS_STAT1), F.in[I_LN1G], F.in[I_LN1B], VW8_DIV / (P8_SCALE * WO8_SCALE)};
        CONV_PRE(CONV_K6, CONV_K9);
        pg8::gemm_phase<EpiResLNB, ProbOutQ, true>(F.lds, P, E);
        CONV_POST(CONV_K6, CONV_K9);
        SEAM(9);
    }
    if (IN(10)) { p_ln2_router(F); SEAM(10); }
    if (IN(12)) {
        build_esched(F, tb, 16);
        ProbExpert<16, true> P{2048, 2048, 2048, F.G, bx, tb, (const unsigned char*)(F.ws + WS_R1), (const unsigned char*)(F.ws + WS_WGU), (size_t)4096 * 2048, (const void*)(F.ws + WS_ELTOK), F.in[I_BG], F.in[I_BU], F.lds + XTRA_OFF};
        if (F.tid < 128) P.table_entry(F.tid, tb + 256 + F.tid * 8);
        __syncthreads();
        EpiSwiGLU E{tb, (unsigned char*)(F.ws + WS_H), F.lds + XTRA_OFF};
        REP(12) pg8::gemm_phase<EpiSwiGLU, ProbExpert<16, true>, true>(F.lds, P, E);
        SEAM(12);
    }
    if (IN(13)) {
        build_esched(F, tb, 8);
        ProbExpert<8, false> P{2048, 2048, 2048, F.G, bx, tb, (const unsigned char*)(F.ws + WS_H), (const unsigned char*)(F.ws + WS_WD), (size_t)2048 * 2048, (const void*)(F.ws + WS_ELGATE), F.in[I_BD], nullptr, F.lds + XTRA_OFF};
        if (F.tid < 128) P.table_entry(F.tid, tb + 256 + F.tid * 8);
        __syncthreads();
        EpiDown E{tb, (unsigned char*)(F.ws + WS_Y), F.lds + XTRA_OFF};
        REP(13) pg8::gemm_phase<EpiDown, ProbExpert<8, false>, true>(F.lds, P, E);
        SEAM(13);
    }
    if (IN(14)) { build_esched(F, tb, 8); p_final(F, tb); }
#undef IN
#undef SEAM
}

extern "C" void kernel_launch(void* const* d_in, const int* in_sizes, int n_in, void* d_out, int out_size, void* d_ws, size_t ws_size, hipStream_t stream) {
    static int grid = 0;
    if (grid == 0) {
        if (n_in != 27 || out_size != NTOK * DM || ws_size < WS_END) { fprintf(stderr, "kernel_launch: unexpected problem (n_in %d, out %d, ws %zu)\n", n_in, out_size, ws_size); grid = -1; return; }
        int dev = 0, cus = 0, per_cu = 0;
        if (hipGetDevice(&dev) != hipSuccess || hipDeviceGetAttribute(&cus, hipDeviceAttributeMultiprocessorCount, dev) != hipSuccess) { grid = -1; return; }
        if (hipFuncSetAttribute((const void*)mk_fwd, hipFuncAttributeMaxDynamicSharedMemorySize, LDS_BYTES) != hipSuccess) { fprintf(stderr, "kernel_launch: hipFuncSetAttribute failed\n"); grid = -1; return; }
        if (hipOccupancyMaxActiveBlocksPerMultiprocessor(&per_cu, (const void*)mk_fwd, NWAVES * 64, LDS_BYTES) != hipSuccess || per_cu < 1) { fprintf(stderr, "kernel_launch: occupancy query says %d\n", per_cu); }
        (void)hipGetLastError();
        if (cus < 128) { fprintf(stderr, "kernel_launch: %d CUs: this kernel's schedules assume the 256-CU MI355X (at least 128)\n", cus); grid = -1; return; }
        grid = cus;
    }
    if (grid < 0) return;
    (void)hipMemsetAsync((char*)d_ws + WS_CTL, 0, CTL_ZERO_BYTES, stream);
    Args a{};
    for (int i = 0; i < 27; ++i) a.in[i] = (const float*)d_in[i];
    a.out = (float*)d_out; a.ws = (unsigned char*)d_ws;
#if MK_ONE_LAUNCH
    a.ph_lo = 0; a.ph_hi = NPHASE;
    hipLaunchKernelGGL(mk_fwd, dim3(grid), dim3(NWAVES * 64), LDS_BYTES, stream, a);
#else
    for (int p = 0; p < NPHASE; ++p) { a.ph_lo = p; a.ph_hi = p + 1; hipLaunchKernelGGL(mk_fwd, dim3(grid), dim3(NWAVES * 64), LDS_BYTES, stream, a); }
#endif
}
```

```cpp
#include <hip/hip_runtime.h>
#include <cstdio>
#include <cstdint>

#ifndef PROBE_MASK
#define PROBE_MASK 0
#endif
#ifndef MK_ONE_LAUNCH
#define MK_ONE_LAUNCH 1
#endif

#define GAS __attribute__((address_space(1)))
#define LAS __attribute__((address_space(3)))
typedef unsigned short bf16_t;
typedef short bf16x8 __attribute__((ext_vector_type(8)));
typedef float f32x4 __attribute__((ext_vector_type(4)));
typedef float f32x16 __attribute__((ext_vector_type(16)));
typedef unsigned u32x4 __attribute__((ext_vector_type(4)));
typedef unsigned u32x2 __attribute__((ext_vector_type(2)));
typedef GAS unsigned gu32;
typedef int v4i32 __attribute__((ext_vector_type(4)));
typedef int v8i32 __attribute__((ext_vector_type(8)));

constexpr int BATCH = 4, SEQ = 8192, DM = 2048, NTOK = BATCH * SEQ;
constexpr int NH = 8, HD = 64, AW = 1024, CW = 1024, PROJ_N = 5120;
constexpr int NMEM = 256, MH = 4, MHD = 512;
constexpr int NE = 32, TOPK = 4, FF = 2048;
constexpr float ALPHA = 1.189207115002721f;
constexpr float LN_EPS = 1e-5f;
constexpr float LOG2E = 1.4426950408889634f;
constexpr float QSCALE = 0.125f * LOG2E;
constexpr float MQSCALE = 0.044194173824159216f * LOG2E;
constexpr float LAMBDA_INIT = 0.2f;
constexpr float SW_LIMIT = 7.0f, SW_ALPHA = 1.702f;
constexpr float ATT_THR = 40.0f;

constexpr size_t MiB = 1u << 20;
constexpr size_t WS_CTL = 0, CTL_ZERO_BYTES = 1 * MiB;
constexpr size_t WS_ELTOK = 1 * MiB;
constexpr size_t WS_ELGATE = 5 * MiB;
constexpr size_t WS_TOKSLOT = 9 * MiB;
constexpr size_t WS_ROUTT = 10 * MiB;
constexpr size_t WS_STAT1 = 10 * MiB + 256 * 1024;
constexpr size_t WS_STAT2 = 10 * MiB + 512 * 1024;
constexpr size_t WS_WINA = 11 * MiB;
constexpr size_t WS_WINV = 31 * MiB;
constexpr size_t WS_WOUT = 35 * MiB;
constexpr size_t WS_WQ = 43 * MiB;
constexpr size_t WS_WKV = 51 * MiB;
constexpr size_t WS_WO = 67 * MiB;
constexpr size_t WS_MEMB = 75 * MiB;
constexpr size_t WS_KMEM = 79 * MiB;
constexpr size_t WS_VMEMT = 83 * MiB;
constexpr size_t WS_WGU = 88 * MiB;
constexpr size_t WS_WD = 344 * MiB;
constexpr size_t WS_R1 = 472 * MiB;
constexpr size_t WS_R2 = 600 * MiB;
constexpr size_t WS_PROJ = WS_R2;
constexpr size_t WS_VT = WS_R2 + 320 * MiB;
constexpr size_t WS_MIX = WS_R2 + 384 * MiB;
constexpr size_t WS_MT = WS_R2;
constexpr size_t WS_VWT = WS_R2 + 8 * MiB;
constexpr size_t WS_P = WS_R2 + 128 * MiB;
constexpr size_t WS_H = WS_R2;
constexpr size_t WS_Y = 1113 * MiB;
constexpr size_t WS_Z = 1625 * MiB;
constexpr size_t WS_END = 1753 * MiB;
constexpr float WG_SCALE = 32.0f, WD_SCALE = 64.0f, WQ8_SCALE = 32.0f, Y_SCALE = 16.0f, WO8_SCALE = 64.0f, M8_DIV = 16.0f, VW8_DIV = 8.0f, P8_SCALE = 256.0f;

constexpr int CW_BAR = 4096;
constexpr int CW_ECNT = 16384;
constexpr int CW_KNMAX = 16512;
constexpr int CW_ATTQ = 16640;
constexpr int CW_RC = 17000;

constexpr int RING_BYTES = 131072;
constexpr int XTRA_OFF = RING_BYTES;
constexpr int MISC_OFF = RING_BYTES + 15360;
constexpr int LDS_BYTES = 147456;
constexpr int NWAVES = 8;

__device__ __forceinline__ unsigned f2bf(float f) { unsigned u = __builtin_bit_cast(unsigned, f); return (u + 0x7fffu + ((u >> 16) & 1u)) >> 16; }
__device__ __forceinline__ unsigned pk2_sw(float lo, float hi) { return f2bf(lo) | (f2bf(hi) << 16); }
__device__ __forceinline__ unsigned cvt_pk_bf16_asm(float lo, float hi) { unsigned r; asm volatile("v_cvt_pk_bf16_f32 %0, %1, %2" : "=v"(r) : "v"(lo), "v"(hi)); return r; }
typedef float f32x2c_t __attribute__((ext_vector_type(2))); typedef __bf16 bf16x2c_t __attribute__((ext_vector_type(2)));
__device__ __forceinline__ unsigned cvt_pk_bf16_c(float lo, float hi) { f32x2c_t v = {lo, hi}; bf16x2c_t b = __builtin_convertvector(v, bf16x2c_t); return __builtin_bit_cast(unsigned, b); }
__device__ __forceinline__ float bflo(unsigned w) { return __uint_as_float(w << 16); }
__device__ __forceinline__ float bfhi(unsigned w) { return __uint_as_float(w & 0xffff0000u); }
__device__ __forceinline__ int opaque(int x) { asm volatile("" : "+v"(x)); return x; }
#define RLX_AGENT __ATOMIC_RELAXED, __HIP_MEMORY_SCOPE_AGENT
#define LDS_WAIT() asm volatile("s_waitcnt lgkmcnt(0)" ::: "memory")
__device__ __forceinline__ float wave_sum(float v) {
#pragma unroll
    for (int o = 1; o < 64; o <<= 1) v += __shfl_xor(v, o);
    return v;
}
__device__ __forceinline__ float wave_max(float v) {
#pragma unroll
    for (int o = 1; o < 64; o <<= 1) v = fmaxf(v, __shfl_xor(v, o));
    return v;
}

__device__ __forceinline__ void glds16v(const void* vptr, unsigned lds_dst) { unsigned keep;
    asm volatile("s_mov_b32 %0, m0\n\ts_mov_b32 m0, %2\n\ts_nop 0\n\tglobal_load_lds_dwordx4 %1, off\n\ts_mov_b32 m0, %0" : "=&s"(keep) : "v"(vptr), "s"(lds_dst) : "memory"); }

#define XB_TMO      128
#define XB_XCNT(j)  (256  + 64 * (j))
#define XB_XSUB(j)  (1280 + 64 * (j))
#define XB_XGEN(j)  (2304 + 64 * (j))
#define XB_TOP      3328
#define XB_TOPGEN   3392
#define XCD_BAR_WORDS 3456
#define XB_SPIN_CAP (1u << 18)
__device__ __forceinline__ unsigned xb_ld(unsigned* p)              { return __hip_atomic_load(p, __ATOMIC_RELAXED, __HIP_MEMORY_SCOPE_AGENT); }
__device__ __forceinline__ unsigned xb_add(unsigned* p, unsigned v) { return __hip_atomic_fetch_add(p, v, __ATOMIC_RELAXED, __HIP_MEMORY_SCOPE_AGENT); }
__device__ __forceinline__ unsigned xb_xcc_id() { return (unsigned)__builtin_amdgcn_s_getreg((3 << 11) | 20) & 0xFu; }
#define XB_SPIN(cond, bar) do { unsigned _sp = 0; while (cond) { __builtin_amdgcn_s_sleep(1); \
    if ((++_sp & 255u) == 0u) { if (xb_ld(&(bar)[XB_TMO])) break; if (_sp > XB_SPIN_CAP) { atomicAdd(&(bar)[XB_TMO], 1u); break; } } } } while (0)
struct XcdBarrier { unsigned* bar; unsigned x; volatile LAS unsigned* st; };
__device__ __forceinline__ XcdBarrier xcd_barrier_post(unsigned* bar, volatile LAS unsigned* st) {
    XcdBarrier b; b.bar = bar; b.x = xb_xcc_id(); b.st = st;
    if (threadIdx.x == 0) (void)xb_add(&bar[XB_XCNT(b.x)], 1u);
    return b;
}
__device__ __forceinline__ void xcd_barrier_complete(unsigned* bar, unsigned x, unsigned& nloc, unsigned& nx) {
    const unsigned G = gridDim.x * gridDim.y * gridDim.z;
    unsigned sum, cnt, mine, sp = 0u;
    for (;;) {
        sum = 0u; cnt = 0u; mine = 0u;
#pragma unroll
        for (unsigned j = 0; j < 16; ++j) { const unsigned c = xb_ld(&bar[XB_XCNT(j)]); sum += c; cnt += (c > 0u) ? 1u : 0u; mine = (j == x) ? c : mine; }
        if (sum == G) break;
        __builtin_amdgcn_s_sleep(1);
        if ((++sp & 255u) == 0u) { if (xb_ld(&bar[XB_TMO])) break; if (sp > XB_SPIN_CAP) { atomicAdd(&bar[XB_TMO], 1u); break; } }
    }
    nloc = mine > 0u ? mine : 1u; nx = cnt > 0u ? cnt : 1u;
}
__device__ __forceinline__ void xcd_barrier(const XcdBarrier& b) {
    asm volatile("s_waitcnt vmcnt(0)" ::: "memory");
    __syncthreads();
    if (threadIdx.x == 0) {
        unsigned* bar = b.bar;
        __builtin_amdgcn_s_waitcnt(0);
        unsigned nloc = b.st[0], nx = b.st[1];
        if (nloc == 0u) { xcd_barrier_complete(bar, b.x, nloc, nx); b.st[0] = nloc; b.st[1] = nx; }
        const unsigned old = xb_add(&bar[XB_XSUB(b.x)], 1u);
        const unsigned gen = old / nloc;
        if (old + 1u == (gen + 1u) * nloc) {
            __builtin_amdgcn_fence(__ATOMIC_RELEASE, "agent");
            asm volatile("s_waitcnt vmcnt(0)" ::: "memory");
            const unsigned og = xb_add(&bar[XB_TOP], 1u);
            const unsigned tg = og / nx;
            if (og + 1u == (tg + 1u) * nx) xb_add(&bar[XB_TOPGEN], 1u);
            else XB_SPIN(xb_ld(&bar[XB_TOPGEN]) == tg, bar);
            __builtin_amdgcn_fence(__ATOMIC_ACQUIRE, "agent");
            xb_add(&bar[XB_XGEN(b.x)], 1u);
            asm volatile("s_waitcnt vmcnt(0)" ::: "memory");
        } else {
            XB_SPIN(xb_ld(&bar[XB_XGEN(b.x)]) == gen, bar);
            __builtin_amdgcn_fence(__ATOMIC_ACQUIRE, "agent");
            asm volatile("s_waitcnt vmcnt(0)" ::: "memory");
        }
    }
    __syncthreads();
}

namespace pg8 {
constexpr int BM = 256, BK = 64, HALF = 128, HTB = HALF * BK * 2, STAGE_BYTES = 8 * HTB, NXCD = 8;
__host__ __device__ __forceinline__ int lds_byte(int r, int c) { const int st = (r >> 4) * 2 + (c >> 5), rr = r & 15, cc = c & 31, ob = rr * 64 + cc * 2; return st * 1024 + (ob ^ (((ob >> 9) & 1) << 5)); }
__host__ __device__ __forceinline__ void stage_rc(int b, int& R, int& C) { const int st = b / 1024, sb = b % 1024, swz = sb ^ (((sb >> 9) & 1) << 5); R = (st >> 1) * 16 + swz / 64; C = (st & 1) * 32 + (swz % 64) / 2; }
__host__ __device__ __forceinline__ int perm32(int rho) { const int n = rho >> 4, i = rho & 15; return 8 * (i >> 2) + 4 * n + (i & 3); }

struct Unit { int pm, pn, g, rs, cnt; };

__device__ __forceinline__ int xcd_chunk(int L, int nwg) { const int q = nwg / NXCD, r = nwg % NXCD, xcd = L % NXCD, off = L / NXCD; return (xcd < r ? xcd * (q + 1) : r * (q + 1) + (xcd - r) * q) + off; }
__device__ __forceinline__ void tile_of(int w, int nM, int nN, int WGM, int& pm, int& pn) { const int nig = WGM * nN, gid = w / nig, fm = gid * WGM, gsz = (nM - fm) < WGM ? (nM - fm) : WGM; pm = fm + ((w % nig) % gsz); pn = (w % nig) / gsz; }

typedef f32x4 Acc[2][2][4][2];

__device__ __forceinline__ void store_tile_bf16(const Acc& acc, bf16_t* O, size_t ldc, int wr, int wc, int fr_, int fq) {
    const int fr = opaque(fr_);
#pragma unroll
    for (int ai = 0; ai < 2; ++ai)
#pragma unroll
        for (int m = 0; m < 4; ++m) { bf16_t* rowp = O + (size_t)(ai * HALF + wr * 64 + m * 16 + fr) * ldc + wc * 32 + 8 * fq;
#pragma unroll
            for (int bj = 0; bj < 2; ++bj) { const f32x4 v0 = acc[ai][bj][m][0], v1 = acc[ai][bj][m][1];
                u32x4 w; w.x = cvt_pk_bf16_c(v0[0], v0[1]); w.y = cvt_pk_bf16_c(v0[2], v0[3]); w.z = cvt_pk_bf16_c(v1[0], v1[1]); w.w = cvt_pk_bf16_c(v1[2], v1[3]);
                *(u32x4*)(rowp + bj * HALF) = w; } }
}

__device__ __forceinline__ u32x4 pair16(u32x2 a, u32x2 b) {
    const auto sx = __builtin_amdgcn_permlane16_swap(a.x, b.x, false, false), sy = __builtin_amdgcn_permlane16_swap(a.y, b.y, false, false);
    u32x4 q; q.x = sx[0]; q.y = sy[0]; q.z = sx[1]; q.w = sy[1]; return q; }
__device__ __forceinline__ u32x2 pack8_fp8(f32x4 v0, f32x4 v1) {
    int p0 = __builtin_amdgcn_cvt_pk_fp8_f32(v0[0], v0[1], 0, false); p0 = __builtin_amdgcn_cvt_pk_fp8_f32(v0[2], v0[3], p0, true);
    int p1 = __builtin_amdgcn_cvt_pk_fp8_f32(v1[0], v1[1], 0, false); p1 = __builtin_amdgcn_cvt_pk_fp8_f32(v1[2], v1[3], p1, true);
    u32x2 w; w.x = (unsigned)p0; w.y = (unsigned)p1; return w; }
__device__ __forceinline__ void store_tile_fp8(const Acc& acc, unsigned char* O, size_t ldc, float scale, int wr, int wc, int fr_, int fq) {
    const int fr = opaque(fr_);
    const int coff = wc * 32 + ((fq & 1) ? HALF + 8 * (fq - 1) : 8 * fq);
#pragma unroll
    for (int ai = 0; ai < 2; ++ai)
#pragma unroll
        for (int m = 0; m < 4; ++m) { unsigned char* rowp = O + (size_t)(ai * HALF + wr * 64 + m * 16 + fr) * ldc + coff;
            const u32x2 w0 = pack8_fp8(acc[ai][0][m][0] * scale, acc[ai][0][m][1] * scale), w1 = pack8_fp8(acc[ai][1][m][0] * scale, acc[ai][1][m][1] * scale);
            *(u32x4*)rowp = pair16(w0, w1); }
}

template <class Prob> struct a_blocked { static constexpr bool value = false; };
template <class Epi, class Prob, bool ALIGN_EPI>
__device__ __forceinline__ void gemm_phase(LAS unsigned char* lds, const Prob& P, const Epi& E) {
    const int tid = threadIdx.x, wid = __builtin_amdgcn_readfirstlane(tid >> 6), lane = tid & 63, wr = wid >> 2, wc = wid & 3, fr = lane & 15, fq = lane >> 4;
    const int nt = P.Kb / 128;
    int Rl[2], Cl[2]; unsigned voffA[2][2], voffAn[2][2], voffB[2];
#pragma unroll
    for (int i = 0; i < 2; ++i) { int R, C; stage_rc(tid * 16 + i * 8192, R, C); Rl[i] = R; Cl[i] = C; const int Rb = Epi::PERM ? ((R & ~31) + perm32(R & 31)) : R;
        voffB[i] = (unsigned)(Rb * P.ldb + C * 2);
        if constexpr (a_blocked<Prob>::value) { const int cb = C * 2;
            voffA[0][i] = (unsigned)((R & ~31) * 2048 + (R & 31) * 32 + (cb >> 5) * 1024 + (cb & 31)); voffA[1][i] = voffA[0][i] + (unsigned)(HALF * 2048); }
        else { voffA[0][i] = (unsigned)(R * P.lda + C * 2); voffA[1][i] = (unsigned)((R + HALF) * P.lda + C * 2); }
        voffAn[0][i] = voffA[0][i]; voffAn[1][i] = voffA[1][i]; }
    const size_t kstep = (size_t)(BK * 2), kstepA = a_blocked<Prob>::value ? (size_t)4096 : kstep;
    const size_t hstepB = (size_t)HALF * P.ldb;
    const unsigned ldsw = (unsigned)wid * 1024u;
    const int aoff = lds_byte(wr * 64 + fr, fq * 8), boff = lds_byte(wc * 32 + fr, fq * 8);
#define PG8_SA(b, h) (((b) * 2 + (h)) * HTB)
#define PG8_SB(b, h) ((4 + (b) * 2 + (h)) * HTB)
#define PG8_STAGE(bufoff, gbase, voff) do { _Pragma("unroll") for (int _i = 0; _i < 2; ++_i) \
        __builtin_amdgcn_global_load_lds((const unsigned*)((const char*)(gbase) + (voff)[_i]), (LAS unsigned*)(lds + (bufoff) + ldsw + _i * 8192), 16, 0, 0); } while (0)
#define PG8_LD8(base_) __builtin_shufflevector(*(const LAS v4i32*)(base_), *(const LAS v4i32*)((base_) + 1024), 0, 1, 2, 3, 4, 5, 6, 7)
#define PG8_LDA(dst, b, h) do { _Pragma("unroll") for (int m = 0; m < 4; ++m) dst[m] = PG8_LD8(lds + PG8_SA(b, h) + aoff + m * 2048); } while (0)
#define PG8_LDB(dst, b, h) do { _Pragma("unroll") for (int n = 0; n < 2; ++n) dst[n] = PG8_LD8(lds + PG8_SB(b, h) + boff + n * 2048); } while (0)
#define PG8_LO(v) __builtin_bit_cast(bf16x8, __builtin_shufflevector(v, v, 0, 1, 2, 3))
#define PG8_HI(v) __builtin_bit_cast(bf16x8, __builtin_shufflevector(v, v, 4, 5, 6, 7))
#define PG8_MMA(ai, bj, At, Bt) do { __builtin_amdgcn_s_setprio(1); _Pragma("unroll") for (int m = 0; m < 4; ++m) _Pragma("unroll") for (int n = 0; n < 2; ++n) { \
        if constexpr (Prob::FP8) { asm volatile("v_mfma_f32_16x16x128_f8f6f4 %0, %1, %2, %0" : "+v"(acc[ai][bj][m][n]) : "v"(Bt[n]), "v"(At[m])); } \
        else { acc[ai][bj][m][n] = __builtin_amdgcn_mfma_f32_16x16x32_bf16(PG8_LO(Bt[n]), PG8_LO(At[m]), acc[ai][bj][m][n], 0, 0, 0); \
               acc[ai][bj][m][n] = __builtin_amdgcn_mfma_f32_16x16x32_bf16(PG8_HI(Bt[n]), PG8_HI(At[m]), acc[ai][bj][m][n], 0, 0, 0); } } __builtin_amdgcn_s_setprio(0); } while (0)
#define PG8_MMAZ(ai, bj, At, Bt) do { __builtin_amdgcn_s_setprio(1); _Pragma("unroll") for (int m = 0; m < 4; ++m) _Pragma("unroll") for (int n = 0; n < 2; ++n) { \
        asm volatile("v_mfma_f32_16x16x128_f8f6f4 %0, %1, %2, 0" : "+v"(acc[ai][bj][m][n]) : "v"(Bt[n]), "v"(At[m])); } __builtin_amdgcn_s_setprio(0); } while (0)
#define PG8_WAIT_V(n) asm volatile("s_waitcnt vmcnt(" #n ")" ::: "memory")
#define PG8_WAIT_L(n) asm volatile("s_waitcnt lgkmcnt(" #n ")" ::: "memory")
#define PG8_BAR __builtin_amdgcn_s_barrier()
#define PG8_SCHED __builtin_amdgcn_sched_barrier(0)
    Unit cur, nxt; int ui = 0;
    if (!P.next(0, cur)) return;
    Acc acc;
#pragma unroll
    for (int a = 0; a < 2; ++a)
#pragma unroll
        for (int b = 0; b < 2; ++b)
#pragma unroll
            for (int m = 0; m < 4; ++m)
#pragma unroll
                for (int n = 0; n < 2; ++n) acc[a][b][m][n] = (f32x4){0.f, 0.f, 0.f, 0.f};
    v8i32 At[4], B0[2], B1[2];
    const char* cA = P.a_base(cur); const char* cB = P.b_base(cur);
    int mslot = 0;
    if constexpr (Prob::META) { P.meta_prefetch(cur, 0, wid, lane); asm volatile("s_waitcnt vmcnt(0)" ::: "memory"); __builtin_amdgcn_s_barrier(); asm volatile("" ::: "memory"); }
    if constexpr (Prob::GATHER) P.a_rows(cur, 0, Rl, Cl, voffA);
    PG8_STAGE(PG8_SB(0, 0), cB, voffB); PG8_STAGE(PG8_SB(0, 1), cB + hstepB, voffB); PG8_STAGE(PG8_SA(0, 0), cA, voffA[0]); PG8_STAGE(PG8_SA(0, 1), cA, voffA[1]);
    if (wr == 1) PG8_BAR;
    PG8_WAIT_V(2); PG8_BAR;
    PG8_STAGE(PG8_SB(1, 0), cB + kstep, voffB); PG8_STAGE(PG8_SA(1, 0), cA + kstepA, voffA[0]); PG8_STAGE(PG8_SB(1, 1), cB + hstepB + kstep, voffB);
    PG8_WAIT_V(6); PG8_BAR;
    for (;;) {
        bool lower_only = false;
        if constexpr (Prob::META) lower_only = P.lower_only(cur);
        const bool has_next = P.next(ui + 1, nxt);
        const char* nA = has_next ? P.a_base(nxt) : cA; const char* nB = has_next ? P.b_base(nxt) : cB;
        const int nslot = (mslot == 2) ? 0 : mslot + 1;
        if constexpr (Prob::META) { if (has_next) P.meta_prefetch(nxt, nslot, wid, lane); }
        for (int t = 0; t < nt; t += 2) {
            const bool last = (t == nt - 2);
            const char* a1 = cA + (size_t)(t + 1) * kstepA;
            const char* a2 = last ? nA : cA + (size_t)(t + 2) * kstepA; const char* b2 = last ? nB : cB + (size_t)(t + 2) * kstep;
            const char* a3 = a2 + kstepA; const char* b3 = b2 + kstep;
            unsigned sA[2][2];
#pragma unroll
            for (int h = 0; h < 2; ++h)
#pragma unroll
                for (int i = 0; i < 2; ++i) sA[h][i] = voffA[h][i];
            if constexpr (Prob::GATHER) { if (last && has_next) { P.a_rows(nxt, nslot, Rl, Cl, voffAn);
#pragma unroll
                for (int h = 0; h < 2; ++h)
#pragma unroll
                    for (int i = 0; i < 2; ++i) sA[h][i] = voffAn[h][i]; } }
            PG8_LDB(B0, 0, 0); PG8_LDB(B1, 0, 1); PG8_SCHED; PG8_LDA(At, 0, 0); PG8_STAGE(PG8_SA(1, 1), a1, voffA[1]);
            PG8_WAIT_V(8); PG8_WAIT_L(0); PG8_BAR; if (Prob::FP8 && t == 0) { PG8_MMAZ(0, 0, At, B0); PG8_MMAZ(0, 1, At, B1); } else { PG8_MMA(0, 0, At, B0); PG8_MMA(0, 1, At, B1); } PG8_BAR; PG8_SCHED;
            PG8_LDA(At, 0, 1); PG8_STAGE(PG8_SB(0, 0), b2, voffB); PG8_STAGE(PG8_SB(0, 1), b2 + hstepB, voffB); PG8_STAGE(PG8_SA(0, 0), a2, sA[0]);
            PG8_WAIT_V(8); PG8_WAIT_L(0); PG8_BAR; if (!lower_only) { if (Prob::FP8 && t == 0) { PG8_MMAZ(1, 0, At, B0); PG8_MMAZ(1, 1, At, B1); } else { PG8_MMA(1, 0, At, B0); PG8_MMA(1, 1, At, B1); } } PG8_BAR; PG8_SCHED;
            PG8_LDB(B0, 1, 0); PG8_LDB(B1, 1, 1); PG8_SCHED; PG8_LDA(At, 1, 0); PG8_STAGE(PG8_SA(0, 1), a2, sA[1]);
            PG8_WAIT_V(8); PG8_WAIT_L(0); PG8_BAR; PG8_MMA(0, 0, At, B0); PG8_MMA(0, 1, At, B1); PG8_BAR; PG8_SCHED;
            PG8_LDA(At, 1, 1); PG8_STAGE(PG8_SB(1, 0), b3, voffB); PG8_STAGE(PG8_SB(1, 1), b3 + hstepB, voffB); PG8_STAGE(PG8_SA(1, 0), a3, sA[0]);
            PG8_WAIT_V(8); PG8_WAIT_L(0); PG8_BAR; if (!lower_only) { PG8_MMA(1, 0, At, B0); PG8_MMA(1, 1, At, B1); } PG8_BAR; PG8_SCHED;
        }
        if constexpr (ALIGN_EPI) { if (wr == 0) PG8_BAR; }
        if constexpr (Prob::FP8) {
#pragma unroll
            for (int a = 0; a < 2; ++a)
#pragma unroll
                for (int b = 0; b < 2; ++b) asm volatile("s_nop 15\n\ts_nop 3" : "+v"(acc[a][b][0][0]), "+v"(acc[a][b][0][1]), "+v"(acc[a][b][1][0]), "+v"(acc[a][b][1][1]), "+v"(acc[a][b][2][0]), "+v"(acc[a][b][2][1]), "+v"(acc[a][b][3][0]), "+v"(acc[a][b][3][1])); }
        if constexpr (Prob::META) E(acc, cur, wr, wc, fr, fq, mslot); else E(acc, cur, wr, wc, fr, fq);
        if (!has_next) break;
        if constexpr (!Prob::FP8) {
#pragma unroll
        for (int a = 0; a < 2; ++a)
#pragma unroll
            for (int b = 0; b < 2; ++b)
#pragma unroll
                for (int m = 0; m < 4; ++m)
#pragma unroll
                    for (int n = 0; n < 2; ++n) acc[a][b][m][n] = (f32x4){0.f, 0.f, 0.f, 0.f}; }
        cur = nxt; cA = nA; cB = nB; ++ui; mslot = nslot;
        if constexpr (Prob::GATHER) {
#pragma unroll
            for (int h = 0; h < 2; ++h)
#pragma unroll
                for (int i = 0; i < 2; ++i) voffA[h][i] = voffAn[h][i]; }
        if constexpr (ALIGN_EPI) { if (wr == 1) PG8_BAR; }
    }
    PG8_WAIT_V(0);
    if constexpr (!ALIGN_EPI) { if (wr == 0) PG8_BAR; }
    PG8_BAR;
#undef PG8_SA
#undef PG8_SB
#undef PG8_STAGE
#undef PG8_LDA
#undef PG8_LD8
#undef PG8_LO
#undef PG8_HI
#undef PG8_LDB
#undef PG8_MMA
#undef PG8_MMAZ
#undef PG8_WAIT_V
#undef PG8_WAIT_L
#undef PG8_BAR
#undef PG8_SCHED
}
}

struct Frame {
    LAS unsigned char* lds;
    gu32* ctl;
    unsigned char* ws;
    int tid, lane, wave, vcu, G;
    const float* in[27];
    float* out;
};
enum { I_X = 0, I_MEM, I_WIN, I_CONVW, I_SUBLN, I_LQ1, I_LK1, I_LQ2, I_LK2, I_WOUT, I_LN1G, I_LN1B, I_MWQ, I_MWKV, I_MWO, I_LN2G, I_LN2B,
       I_RW, I_RB, I_WG, I_BG, I_WU, I_BU, I_WD, I_BD, I_LN3G, I_LN3B };

struct P0Item { const float* W; unsigned char* WT; int row_off; float scale; int k0, n0; };
__device__ __forceinline__ P0Item p0_expert_item(const Frame& F, int it) {
    P0Item I; const int mtx0 = it / 1024 + 1, rr = it % 1024, kb = rr / 64, nb = rr % 64; I.k0 = 128 * kb; I.n0 = 32 * nb;
    const size_t esz = (size_t)2048 * 2048;
    if (mtx0 == 1) { I.W = F.in[I_MWO]; I.WT = F.ws + WS_WO; I.row_off = 0; I.scale = WO8_SCALE; return I; }
    const int mtx = mtx0 - 2, e = mtx / 3, which = mtx % 3;
    if (which == 0)      { I.W = F.in[I_WG] + e * esz; I.WT = F.ws + WS_WGU + (size_t)e * 2 * esz; I.row_off = (I.n0 / 128) * 256 + (I.n0 % 128) - I.n0; I.scale = WG_SCALE; }
    else if (which == 1) { I.W = F.in[I_WU] + e * esz; I.WT = F.ws + WS_WGU + (size_t)e * 2 * esz; I.row_off = (I.n0 / 128) * 256 + 128 + (I.n0 % 128) - I.n0; I.scale = WG_SCALE; }
    else                 { I.W = F.in[I_WD] + e * esz; I.WT = F.ws + WS_WD + (size_t)e * esz; I.row_off = 0; I.scale = WD_SCALE; }
    return I;
}
__device__ __forceinline__ void p0_expert_load(const P0Item& I, f32x4 (&v)[16], int lane) {
#pragma unroll
    for (int i = 0; i < 16; ++i) v[i] = __builtin_nontemporal_load((const f32x4*)(I.W + (size_t)(I.k0 + 8 * i + (lane >> 3)) * 2048 + I.n0 + 4 * (lane & 7)));
}
__device__ __forceinline__ void p0_expert_store(const P0Item& I, const f32x4 (&v)[16], LAS float* scr, int lane) {
#pragma unroll
    for (int i = 0; i < 16; ++i) { LAS float* d = scr + (8 * i + (lane >> 3)) * 33 + 4 * ((lane & 7) ^ (i >> 1)); d[0] = v[i][0] * I.scale; d[1] = v[i][1] * I.scale; d[2] = v[i][2] * I.scale; d[3] = v[i][3] * I.scale; }
    LDS_WAIT(); asm volatile("" ::: "memory");
    const int q = lane & 7;
#pragma unroll
    for (int j = 0; j < 4; ++j) { const int n = (lane >> 3) + 8 * j; const LAS float* sp = scr + (16 * q) * 33 + (n ^ (q << 2)); u32x4 o;
#pragma unroll
        for (int d = 0; d < 4; ++d) { int p = __builtin_amdgcn_cvt_pk_fp8_f32(sp[(4 * d + 0) * 33], sp[(4 * d + 1) * 33], 0, false); p = __builtin_amdgcn_cvt_pk_fp8_f32(sp[(4 * d + 2) * 33], sp[(4 * d + 3) * 33], p, true); o[d] = (unsigned)p; }
        *(GAS u32x4*)(I.WT + (size_t)(I.row_off + I.n0 + n) * 2048 + I.k0 + 16 * q) = o; }
    LDS_WAIT(); asm volatile("" ::: "memory");
}
__device__ __forceinline__ void row_to_bf16(const float* xrow, bf16_t* orow, int lane) {
    const GAS f32x4* xr = (const GAS f32x4*)xrow + lane; GAS u32x2* o8 = (GAS u32x2*)orow + lane;
    f32x4 v[8];
#pragma unroll
    for (int j = 0; j < 8; ++j) v[j] = xr[64 * j];
#pragma unroll
    for (int j = 0; j < 8; ++j) { u32x2 w; w.x = cvt_pk_bf16_c(v[j].x, v[j].y); w.y = cvt_pk_bf16_c(v[j].z, v[j].w); o8[64 * j] = w; }
}
constexpr int CONV_NEXP = 97 * 1024, CONV_KEND = 49;
#define CONV_PRE(ka, kb) do { if (!(F.vcu & 1)) { p0_conv_range(F, ka, kb); __syncthreads(); } } while (0)
#define CONV_POST(ka, kb) do { if (F.vcu & 1) { __syncthreads(); p0_conv_range(F, ka, kb); } } while (0)
#define CONV_KS ((2048 + F.G * NWAVES - 1) / (F.G * NWAVES) - 1)
#define CONV_K0 (1 + CONV_KS)
#define CONV_K1 (19 + CONV_KS)
#define CONV_K3 (31 + CONV_KS)
#define CONV_K4 (39 + CONV_KS)
#define CONV_K6 (43 + CONV_KS)
#define CONV_K9 (1 << 20)
__device__ __forceinline__ void p0_conv_range(Frame& F, int kb, int ke) {
    const int gw = __builtin_amdgcn_readfirstlane(opaque(F.vcu * NWAVES + F.wave)), NGW = F.G * NWAVES;
    LAS float* scr2 = (LAS float*)(F.lds + F.wave * 17408);
    f32x4 va[16], vb[16];
    if (ke > CONV_NEXP / NGW + 2) ke = CONV_NEXP / NGW + 2;
    int it = gw + kb * NGW; const int itend = gw + ke * NGW;
    if (it < CONV_NEXP && it < itend) { P0Item Ia = p0_expert_item(F, it); p0_expert_load(Ia, va, F.lane);
        for (;;) {
            const int itb = it + NGW; const bool hb = itb < CONV_NEXP && itb < itend; P0Item Ib = Ia;
            if (hb) { Ib = p0_expert_item(F, itb); p0_expert_load(Ib, vb, F.lane); }
            p0_expert_store(Ia, va, scr2, F.lane);
            if (!hb) break;
            const int itc = itb + NGW; const bool hc = itc < CONV_NEXP && itc < itend;
            if (hc) { Ia = p0_expert_item(F, itc); p0_expert_load(Ia, va, F.lane); }
            p0_expert_store(Ib, vb, scr2, F.lane);
            if (!hc) break;
            it = itc;
        }
    }
}
struct SItem { const float* W; bf16_t* WT; int N, k0, n0, row_off; float scale; };
__device__ __forceinline__ SItem p0_small_item(const Frame& F, int it) {
    constexpr int I_IN = 32 * 192, I_SQ = 32 * 64;
    SItem I; int r = it;
    if (r < I_IN) { const int kb = r / 192, nb = r % 192, n0 = nb * 32; I.W = F.in[I_WIN]; I.N = 6144; I.k0 = 64 * kb; I.n0 = n0;
        if (n0 < 2048) { I.WT = (bf16_t*)(F.ws + WS_WINA); I.row_off = 0; I.scale = n0 < 1024 ? QSCALE : 1.f; }
        else if (n0 < 3072) { I.WT = (bf16_t*)(F.ws + WS_WINV); I.row_off = -2048; I.scale = 1.f; }
        else { I.WT = (bf16_t*)(F.ws + WS_WINA); I.row_off = -1024; I.scale = 1.f; }
        return I; }
    r -= I_IN;
    if (r < I_SQ) { I.W = F.in[I_WOUT]; I.N = 2048; I.k0 = 64 * (r / 64); I.n0 = 32 * (r % 64); I.WT = (bf16_t*)(F.ws + WS_WOUT); I.row_off = 0; I.scale = 1.f; return I; }
    r -= I_SQ;
    I.W = F.in[I_MWKV]; I.N = 4096; I.k0 = 64 * (r / 128); I.n0 = 32 * (r % 128); I.WT = (bf16_t*)(F.ws + WS_WKV); I.row_off = 0; I.scale = 1.f; return I;
}
__device__ __forceinline__ void p0_small_load(const SItem& I, f32x4 (&v)[8], int lane) {
#pragma unroll
    for (int i = 0; i < 8; ++i) v[i] = __builtin_nontemporal_load((const f32x4*)(I.W + (size_t)(I.k0 + 8 * i + (lane >> 3)) * I.N + I.n0 + 4 * (lane & 7)));
}
__device__ __forceinline__ void p0_small_store(const SItem& I, const f32x4 (&v)[8], LAS float* scr, int lane) {
#pragma unroll
    for (int i = 0; i < 8; ++i) { LAS float* d = scr + (8 * i + (lane >> 3)) * 33 + 4 * (lane & 7); d[0] = v[i][0] * I.scale; d[1] = v[i][1] * I.scale; d[2] = v[i][2] * I.scale; d[3] = v[i][3] * I.scale; }
    LDS_WAIT(); asm volatile("" ::: "memory");
    const int c = lane & 7;
#pragma unroll
    for (int j = 0; j < 4; ++j) { const int n = (lane >> 3) + 8 * j; const LAS float* sp = scr + (8 * c) * 33 + n;
        u32x4 o; o.x = cvt_pk_bf16_c(sp[0 * 33], sp[1 * 33]); o.y = cvt_pk_bf16_c(sp[2 * 33], sp[3 * 33]); o.z = cvt_pk_bf16_c(sp[4 * 33], sp[5 * 33]); o.w = cvt_pk_bf16_c(sp[6 * 33], sp[7 * 33]);
        *(GAS u32x4*)(I.WT + (size_t)(I.row_off + I.n0 + n) * 2048 + I.k0 + 8 * c) = o; }
    LDS_WAIT(); asm volatile("" ::: "memory");
}
__device__ __forceinline__ void p0_prologue(Frame& F) {
    LAS float* scr = (LAS float*)(F.lds + F.wave * 17408);
    const int gw = F.vcu * NWAVES + F.wave, NGW = F.G * NWAVES;
    bf16_t* winA = (bf16_t*)(F.ws + WS_WINA); bf16_t* winV = (bf16_t*)(F.ws + WS_WINV);
    constexpr int I_IN = 32 * 192, I_SQ = 32 * 64, I_KV = 32 * 128;
    constexpr int NSMALL = I_IN + 1 * I_SQ + I_KV;
    if (gw < NSMALL) {
        f32x4 va[8], vb[8]; int it = gw; SItem Ia = p0_small_item(F, it); p0_small_load(Ia, va, F.lane);
        for (;;) {
            const int itb = it + NGW; const bool hb = itb < NSMALL; SItem Ib = Ia;
            if (hb) { Ib = p0_small_item(F, itb); p0_small_load(Ib, vb, F.lane); }
            p0_small_store(Ia, va, scr, F.lane);
            if (!hb) break;
            const int itc = itb + NGW; const bool hc = itc < NSMALL;
            if (hc) { Ia = p0_small_item(F, itc); p0_small_load(Ia, va, F.lane); }
            p0_small_store(Ib, vb, scr, F.lane);
            if (!hc) break;
            it = itc;
        }
    }
    p0_conv_range(F, 0, CONV_K0);
    {
        const float* xin = F.in[I_X]; bf16_t* xb = (bf16_t*)(F.ws + WS_R1);
        for (int m = gw; m < NTOK; m += 2 * NGW) { const int m2 = m + NGW; const bool h2 = m2 < NTOK;
            const GAS f32x4* x1 = (const GAS f32x4*)(xin + (size_t)m * DM) + F.lane; const GAS f32x4* x2 = (const GAS f32x4*)(xin + (size_t)(h2 ? m2 : m) * DM) + F.lane;
            f32x4 a[8], b[8];
#pragma unroll
            for (int j = 0; j < 8; ++j) a[j] = __builtin_nontemporal_load(x1 + 64 * j);
#pragma unroll
            for (int j = 0; j < 8; ++j) b[j] = __builtin_nontemporal_load(x2 + 64 * j);
            GAS u32x2* o1 = (GAS u32x2*)(xb + (size_t)m * DM) + F.lane; GAS u32x2* o2 = (GAS u32x2*)(xb + (size_t)m2 * DM) + F.lane;
#pragma unroll
            for (int j = 0; j < 8; ++j) { u32x2 w; w.x = cvt_pk_bf16_c(a[j].x, a[j].y); w.y = cvt_pk_bf16_c(a[j].z, a[j].w); o1[64 * j] = w; }
            if (h2) {
#pragma unroll
                for (int j = 0; j < 8; ++j) { u32x2 w; w.x = cvt_pk_bf16_c(b[j].x, b[j].y); w.y = cvt_pk_bf16_c(b[j].z, b[j].w); o2[64 * j] = w; } }
        }
    }
    {
        const float* wq = F.in[I_MWQ]; unsigned char* wqn = F.ws + WS_WQ;
        for (int m = gw; m < DM; m += NGW) { const GAS f32x4* xr = (const GAS f32x4*)(wq + (size_t)m * DM) + F.lane; GAS unsigned* o4 = (GAS unsigned*)(wqn + (size_t)m * DM) + F.lane;
            f32x4 v[8];
#pragma unroll
            for (int j = 0; j < 8; ++j) v[j] = __builtin_nontemporal_load(xr + 64 * j);
#pragma unroll
            for (int j = 0; j < 8; ++j) { int p = __builtin_amdgcn_cvt_pk_fp8_f32(v[j].x * WQ8_SCALE, v[j].y * WQ8_SCALE, 0, false); p = __builtin_amdgcn_cvt_pk_fp8_f32(v[j].z * WQ8_SCALE, v[j].w * WQ8_SCALE, p, true); o4[64 * j] = (unsigned)p; } }
    }
    for (int m = gw; m < BATCH * NMEM; m += NGW) row_to_bf16(F.in[I_MEM] + (size_t)m * DM, (bf16_t*)(F.ws + WS_MEMB) + (size_t)m * DM, F.lane);
    { bf16_t* rt = (bf16_t*)(F.ws + WS_ROUTT); const float* rw = F.in[I_RW]; const float* g2 = F.in[I_LN2G];
      for (int i = gw * 64 + F.lane; i < 2048 * 32; i += NGW * 64) { const int k = i >> 5, e = i & 31; const float w = rw[i] * g2[k]; const unsigned wh = f2bf(w);
          rt[e * 2048 + k] = (bf16_t)wh; rt[32 * 2048 + e * 2048 + k] = (bf16_t)f2bf(w - __uint_as_float(wh << 16)); } }
    for (int v = F.vcu; v < 64; v += F.G) {
        const int e = v & 31; const float* vec = (v >> 5) ? F.in[I_LN2B] : F.in[I_LN2G]; const float* rw = F.in[I_RW];
        float a = 0.f;
        for (int k = F.tid; k < 2048; k += NWAVES * 64) a += vec[k] * rw[k * 32 + e];
        a = wave_sum(a);
        __syncthreads();
        if (F.lane == 0) ((LAS float*)(F.lds + F.wave * 17408))[0] = a;
        __syncthreads();
        if (F.tid == 0) { float t = 0.f; for (int w = 0; w < NWAVES; ++w) t += ((LAS float*)(F.lds + w * 17408))[0]; if (v >> 5) t += F.in[I_RB][e]; ((float*)(F.ctl))[CW_RC + v] = t; }
    }
}

struct ProbP1 {
    static constexpr bool META = false, GATHER = false, FP8 = false;
    int Kb, lda, ldb, G, c;
    const bf16_t *xb, *winA, *winV, *wkvT, *memb;
    static constexpr int U0 = 128 * 20, U1 = U0 + 4 * 128;
    __device__ __forceinline__ bool next(int i, pg8::Unit& u) const {
        const int L = i * G + c; if (L >= U1) return false;
        const int w = pg8::xcd_chunk(L, U1);
        if (w < U0) { u.g = 0; pg8::tile_of(w, 128, 20, 8, u.pm, u.pn); }
        else { u.g = 1; pg8::tile_of(w - U0, 4, 128, 4, u.pm, u.pn); }
        return true;
    }
    __device__ __forceinline__ const char* a_base(const pg8::Unit& u) const {
        const bf16_t* p = u.g == 0 ? xb : winV;
        return (const char*)(p + (size_t)u.pm * 256 * 2048); }
    __device__ __forceinline__ const char* b_base(const pg8::Unit& u) const {
        const bf16_t* p = u.g == 0 ? winA : xb;
        return (const char*)(p + (size_t)u.pn * 256 * 2048); }
};
struct ProbKV {
    static constexpr bool META = false, GATHER = false, FP8 = false;
    int Kb, lda, ldb, c;
    const bf16_t *wkvT, *memb;
    __device__ __forceinline__ bool next(int i, pg8::Unit& u) const { if (i > 0 || c >= 64) return false; u.g = 2; u.pm = c >> 4; u.pn = c & 15; return true; }
    __device__ __forceinline__ const char* a_base(const pg8::Unit& u) const { return (const char*)(memb + (size_t)u.pm * 256 * 2048); }
    __device__ __forceinline__ const char* b_base(const pg8::Unit& u) const { return (const char*)(wkvT + (size_t)u.pn * 256 * 2048); }
};
struct EpiP1 {
    static constexpr bool PERM = true;
    bf16_t *proj, *VT; unsigned char *kmem, *vmem; gu32* ctl; LAS float* kt;
    __device__ __forceinline__ void operator()(const pg8::Acc& acc, const pg8::Unit& u, int wr, int wc, int fr_, int fq) const {
        if (u.g == 0 && (u.pn >> 2) == 1) {
            const int fr = opaque(fr_);
#pragma unroll
            for (int ai = 0; ai < 2; ++ai)
#pragma unroll
                for (int m = 0; m < 4; ++m) { const int row = ai * 128 + wr * 64 + m * 16 + fr; bf16_t* rowp = proj + (size_t)(u.pm * 256 + row) * PROJ_N + u.pn * 256 + wc * 32 + 8 * fq;
#pragma unroll
                    for (int bj = 0; bj < 2; ++bj) { const f32x4 v0 = acc[ai][bj][m][0], v1 = acc[ai][bj][m][1];
                        u32x4 w; w.x = cvt_pk_bf16_c(v0[0], v0[1]); w.y = cvt_pk_bf16_c(v0[2], v0[3]); w.z = cvt_pk_bf16_c(v1[0], v1[1]); w.w = cvt_pk_bf16_c(v1[2], v1[3]);
                        *(u32x4*)(rowp + bj * 128) = w;
                        float ss = 0.f;
#pragma unroll
                        for (int j = 0; j < 4; ++j) ss += bflo(w[j]) * bflo(w[j]) + bfhi(w[j]) * bfhi(w[j]);
                        ss += __shfl_xor(ss, 16); ss += __shfl_xor(ss, 32);
                        if (fq == 0) kt[row * 8 + bj * 4 + wc] = ss; } }
            asm volatile("s_waitcnt lgkmcnt(0)" ::: "memory"); __builtin_amdgcn_s_barrier(); asm volatile("" ::: "memory");
            if (wr == 0) { const int row = wc * 64 + (fr + 16 * fq); const f32x4 a = *(const LAS f32x4*)(kt + row * 8), b = *(const LAS f32x4*)(kt + row * 8 + 4);
                float g0 = a.x + a.y, g1 = a.z + a.w, g2 = b.x + b.y, g3 = b.z + b.w;
                g0 = wave_max(g0); g1 = wave_max(g1); g2 = wave_max(g2); g3 = wave_max(g3);
                if (fr + 16 * fq == 0) { unsigned* kn = (unsigned*)(ctl + CW_KNMAX) + (u.pm >> 5) * 16 + (u.pn - 4) * 4;
                    atomicMax(kn, __float_as_uint(g0)); atomicMax(kn + 1, __float_as_uint(g1)); atomicMax(kn + 2, __float_as_uint(g2)); atomicMax(kn + 3, __float_as_uint(g3)); } }
            return; }
        if (u.g == 1) {
            const int fr = opaque(fr_);
#pragma unroll
            for (int ai = 0; ai < 2; ++ai)
#pragma unroll
                for (int m = 0; m < 4; ++m) { const int dg = u.pm * 256 + ai * 128 + wr * 64 + m * 16 + fr;
#pragma unroll
                    for (int bj = 0; bj < 2; ++bj) { const int tok = u.pn * 256 + bj * 128 + wc * 32 + 8 * fq, b = tok >> 13, t = tok & (SEQ - 1);
                        bf16_t* p = VT + ((size_t)((b * NH + (dg >> 7)) * 128 + (t >> 6)) * 8192 + (dg & 127) * 64 + (t & 63));
                        const f32x4 v0 = acc[ai][bj][m][0], v1 = acc[ai][bj][m][1];
                        u32x4 w; w.x = cvt_pk_bf16_c(v0[0], v0[1]); w.y = cvt_pk_bf16_c(v0[2], v0[3]); w.z = cvt_pk_bf16_c(v1[0], v1[1]); w.w = cvt_pk_bf16_c(v1[2], v1[3]);
                        *(u32x4*)p = w; } }
            return; }
        if (u.g == 2) { pg8::store_tile_fp8(acc, (u.pn < 8 ? kmem : vmem) + (size_t)u.pm * 256 * 2048 + (size_t)(u.pn & 7) * 256, 2048, 1.0f, wr, wc, fr_, fq); return; }
        pg8::store_tile_bf16(acc, proj + (size_t)u.pm * 256 * PROJ_N + (size_t)u.pn * 256, PROJ_N, wr, wc, fr_, fq);
    }
};

struct ProbDense {
    static constexpr bool META = false, GATHER = false, FP8 = false;
    int Kb, lda, ldb, G, c, nM, nN;
    const bf16_t *A, *Bt;
    __device__ __forceinline__ bool next(int i, pg8::Unit& u) const {
        const int L = i * G + c, nwg = nM * nN; if (L >= nwg) return false;
        u.g = 0; pg8::tile_of(pg8::xcd_chunk(L, nwg), nM, nN, 8, u.pm, u.pn); return true; }
    __device__ __forceinline__ const char* a_base(const pg8::Unit& u) const { return (const char*)A + (size_t)u.pm * 256 * lda; }
    __device__ __forceinline__ const char* b_base(const pg8::Unit& u) const { return (const char*)Bt + (size_t)u.pn * 256 * ldb; }
};
struct ProbDenseQ {
    static constexpr bool META = false, GATHER = false, FP8 = true;
    int Kb, lda, ldb, G, c, nM, nN;
    const unsigned char *A, *Bt;
    __device__ __forceinline__ bool next(int i, pg8::Unit& u) const {
        const int L = i * G + c, nwg = nM * nN; if (L >= nwg) return false;
        u.g = 0; pg8::tile_of(pg8::xcd_chunk(L, nwg), nM, nN, 8, u.pm, u.pn); return true; }
    __device__ __forceinline__ const char* a_base(const pg8::Unit& u) const { return (const char*)A + (size_t)u.pm * 256 * lda; }
    __device__ __forceinline__ const char* b_base(const pg8::Unit& u) const { return (const char*)Bt + (size_t)u.pn * 256 * ldb; }
};
struct EpiFp8S {
    static constexpr bool PERM = true;
    unsigned char* O; size_t ldc; float scale;
    __device__ __forceinline__ void operator()(const pg8::Acc& acc, const pg8::Unit& u, int wr, int wc, int fr, int fq) const {
        pg8::store_tile_fp8(acc, O + (size_t)u.pm * 256 * ldc + (size_t)u.pn * 256, ldc, scale, wr, wc, fr, fq); }
};
struct EpiBf16S {
    static constexpr bool PERM = true;
    bf16_t* O; size_t ldc; float scale;
    __device__ __forceinline__ void operator()(pg8::Acc& acc, const pg8::Unit& u, int wr, int wc, int fr, int fq) const {
#pragma unroll
        for (int ai = 0; ai < 2; ++ai)
#pragma unroll
            for (int bj = 0; bj < 2; ++bj)
#pragma unroll
                for (int m = 0; m < 4; ++m)
#pragma unroll
                    for (int n = 0; n < 2; ++n) acc[ai][bj][m][n] = acc[ai][bj][m][n] * scale;
        pg8::store_tile_bf16(acc, O + (size_t)u.pm * 256 * ldc + (size_t)u.pn * 256, ldc, wr, wc, fr, fq); }
};
struct EpiBf16 {
    static constexpr bool PERM = true;
    bf16_t* O; size_t ldc;
    __device__ __forceinline__ void operator()(const pg8::Acc& acc, const pg8::Unit& u, int wr, int wc, int fr, int fq) const {
        pg8::store_tile_bf16(acc, O + (size_t)u.pm * 256 * ldc + (size_t)u.pn * 256, ldc, wr, wc, fr, fq); }
};
struct EpiResB {
    static constexpr bool PERM = true;
    const bf16_t* res; bf16_t* out;
    __device__ __forceinline__ void operator()(const pg8::Acc& acc, const pg8::Unit& u, int wr, int wc, int fr_, int fq) const {
        const int fr = opaque(fr_);
        u32x4 rv[2][4][2];
#pragma unroll
        for (int ai = 0; ai < 2; ++ai)
#pragma unroll
            for (int m = 0; m < 4; ++m) { const size_t off = (size_t)(u.pm * 256 + ai * 128 + wr * 64 + m * 16 + fr) * DM + u.pn * 256 + wc * 32 + 8 * fq;
#pragma unroll
                for (int bj = 0; bj < 2; ++bj) rv[ai][m][bj] = *(const u32x4*)(res + off + bj * 128); }
        __builtin_amdgcn_sched_barrier(0);
#pragma unroll
        for (int ai = 0; ai < 2; ++ai) {
#pragma unroll
            for (int m = 0; m < 4; ++m) { const size_t off = (size_t)(u.pm * 256 + ai * 128 + wr * 64 + m * 16 + fr) * DM + u.pn * 256 + wc * 32 + 8 * fq;
#pragma unroll
                for (int bj = 0; bj < 2; ++bj) { const u32x4 r = rv[ai][m][bj]; const f32x4 v0 = acc[ai][bj][m][0], v1 = acc[ai][bj][m][1];
                    u32x4 w; w.x = cvt_pk_bf16_c(v0[0] + ALPHA * bflo(r.x), v0[1] + ALPHA * bfhi(r.x)); w.y = cvt_pk_bf16_c(v0[2] + ALPHA * bflo(r.y), v0[3] + ALPHA * bfhi(r.y));
                    w.z = cvt_pk_bf16_c(v1[0] + ALPHA * bflo(r.z), v1[1] + ALPHA * bfhi(r.z)); w.w = cvt_pk_bf16_c(v1[2] + ALPHA * bflo(r.w), v1[3] + ALPHA * bfhi(r.w));
                    *(u32x4*)(out + off + bj * 128) = w; } }
            __builtin_amdgcn_sched_barrier(0); }
    }
};

struct EpiResLNB {
    static constexpr bool PERM = true;
    const bf16_t* z; bf16_t* out; const float* stats; const float* gam; const float* bet; float ascale;
    __device__ __forceinline__ void operator()(const pg8::Acc& acc, const pg8::Unit& u, int wr, int wc, int fr_, int fq) const {
        const int fr = opaque(fr_);
        const int col0 = u.pn * 256 + wc * 32 + 8 * fq;
        f32x4 gv[2][2], bv[2][2];
#pragma unroll
        for (int bj = 0; bj < 2; ++bj)
#pragma unroll
            for (int n = 0; n < 2; ++n) { gv[bj][n] = *(const f32x4*)(gam + col0 + bj * 128 + n * 4) * ALPHA; bv[bj][n] = *(const f32x4*)(bet + col0 + bj * 128 + n * 4) * ALPHA; }
#pragma unroll
        for (int ai = 0; ai < 2; ++ai) {
            u32x4 rv[4][2]; float mean[4], rstd[4];
#pragma unroll
            for (int m = 0; m < 4; ++m) { const int row = u.pm * 256 + ai * 128 + wr * 64 + m * 16 + fr; const size_t off = (size_t)row * DM + col0;
                mean[m] = stats[2 * row]; rstd[m] = stats[2 * row + 1];
#pragma unroll
                for (int bj = 0; bj < 2; ++bj) rv[m][bj] = *(const u32x4*)(z + off + bj * 128); }
            __builtin_amdgcn_sched_barrier(0);
#pragma unroll
            for (int m = 0; m < 4; ++m) { const int row = u.pm * 256 + ai * 128 + wr * 64 + m * 16 + fr; const size_t off = (size_t)row * DM + col0;
#pragma unroll
                for (int bj = 0; bj < 2; ++bj) { const u32x4 r = rv[m][bj];
                    const f32x4 r0 = {bflo(r.x), bfhi(r.x), bflo(r.y), bfhi(r.y)}, r1 = {bflo(r.z), bfhi(r.z), bflo(r.w), bfhi(r.w)};
                    const f32x4 o0 = acc[ai][bj][m][0] * ascale + ((r0 - mean[m]) * rstd[m]) * gv[bj][0] + bv[bj][0], o1 = acc[ai][bj][m][1] * ascale + ((r1 - mean[m]) * rstd[m]) * gv[bj][1] + bv[bj][1];
                    u32x4 w; w.x = cvt_pk_bf16_c(o0[0], o0[1]); w.y = cvt_pk_bf16_c(o0[2], o0[3]); w.z = cvt_pk_bf16_c(o1[0], o1[1]); w.w = cvt_pk_bf16_c(o1[2], o1[3]);
                    *(u32x4*)(out + off + bj * 128) = w; } }
            __builtin_amdgcn_sched_barrier(0); }
    }
};

template <int T>
__device__ __forceinline__ void p2_conv(Frame& F) {
    const bf16_t* proj = (const bf16_t*)(F.ws + WS_PROJ); bf16_t* mix = (bf16_t*)(F.ws + WS_MIX);
    const float* cw = F.in[I_CONVW];
    const int gt = opaque(F.vcu * 512) + F.tid, NT = F.G * 512;
    for (int it = gt; it < (NTOK / T) * 128; it += NT) {
        const int tb8 = it >> 7, cg = it & 127, c0 = cg * 8, tok0 = tb8 * T, t0 = tok0 & (SEQ - 1);
        const bf16_t* row0 = proj + (size_t)tok0 * PROJ_N;
        const f32x4 w0a = *(const f32x4*)(cw + c0), w0b = *(const f32x4*)(cw + c0 + 4), w1a = *(const f32x4*)(cw + CW + c0), w1b = *(const f32x4*)(cw + CW + c0 + 4), w2a = *(const f32x4*)(cw + 2 * CW + c0), w2b = *(const f32x4*)(cw + 2 * CW + c0 + 4);
        const float w0[8] = {w0a[0], w0a[1], w0a[2], w0a[3], w0b[0], w0b[1], w0b[2], w0b[3]};
        const float w1[8] = {w1a[0], w1a[1], w1a[2], w1a[3], w1b[0], w1b[1], w1b[2], w1b[3]};
        const float w2[8] = {w2a[0], w2a[1], w2a[2], w2a[3], w2b[0], w2b[1], w2b[2], w2b[3]};
        u32x4 cv[T + 2], uv[T + 2], gv[T];
#pragma unroll
        for (int r = 0; r < T + 2; ++r) { const int t = t0 - 1 + r; const bool ok = (t >= 0) && (t < SEQ); const bf16_t* rp = row0 + (ptrdiff_t)(r - 1) * PROJ_N;
            cv[r] = ok ? *(const u32x4*)(rp + 3072 + c0) : (u32x4){0, 0, 0, 0}; uv[r] = ok ? *(const u32x4*)(rp + 4096 + c0) : (u32x4){0, 0, 0, 0}; }
#pragma unroll
        for (int r = 0; r < T; ++r) gv[r] = *(const u32x4*)(row0 + (size_t)r * PROJ_N + 2048 + c0);
        float pm[8], pc[8], pn[8];
#pragma unroll
        for (int j = 0; j < 4; ++j) { pm[2 * j] = bflo(cv[0][j]) * bflo(uv[0][j]); pm[2 * j + 1] = bfhi(cv[0][j]) * bfhi(uv[0][j]); pc[2 * j] = bflo(cv[1][j]) * bflo(uv[1][j]); pc[2 * j + 1] = bfhi(cv[1][j]) * bfhi(uv[1][j]); }
#pragma unroll
        for (int r = 0; r < T; ++r) {
#pragma unroll
            for (int j = 0; j < 4; ++j) { pn[2 * j] = bflo(cv[r + 2][j]) * bflo(uv[r + 2][j]); pn[2 * j + 1] = bfhi(cv[r + 2][j]) * bfhi(uv[r + 2][j]); }
            u32x4 o;
#pragma unroll
            for (int j = 0; j < 4; ++j) {
                const float lo = bflo(gv[r][j]) * (w0[2 * j] * pm[2 * j] + w1[2 * j] * pc[2 * j] + w2[2 * j] * pn[2 * j]);
                const float hi = bfhi(gv[r][j]) * (w0[2 * j + 1] * pm[2 * j + 1] + w1[2 * j + 1] * pc[2 * j + 1] + w2[2 * j + 1] * pn[2 * j + 1]);
                o[j] = cvt_pk_bf16_c(lo, hi); }
            *(u32x4*)(mix + (size_t)(tok0 + r) * DM + AW + c0) = o;
#pragma unroll
            for (int j = 0; j < 8; ++j) { pm[j] = pc[j]; pc[j] = pn[j]; }
        }
    }
}
__device__ __forceinline__ int pi_swap(int r) { return (r & ~12) | ((r & 4) << 1) | ((r & 8) >> 1); }
__device__ __forceinline__ void glds16(const void* sbase, unsigned voff, unsigned lds_dst) { unsigned keep;
    asm volatile("s_mov_b32 %0, m0\n\ts_mov_b32 m0, %3\n\ts_nop 0\n\tglobal_load_lds_dwordx4 %1, %2\n\ts_mov_b32 m0, %0" : "=&s"(keep) : "v"(voff), "s"(sbase), "s"(lds_dst) : "memory"); }
#define ATT_WAIT_BAR() asm volatile("s_waitcnt vmcnt(0) lgkmcnt(0)\n\ts_barrier" ::: "memory")
__device__ __forceinline__ int att_take(gu32* aq, int myq, int& qk) {
    while (qk < 8) { const int q = (myq + qk) & 7; const unsigned t = __hip_atomic_fetch_add((unsigned*)(aq + q * 32), 1u, RLX_AGENT); if (t < 256u) return q * 256 + (int)t; ++qk; }
    return -1;
}
template <class Mid>
__device__ __forceinline__ void p3_attention(Frame& F, const Mid& after_first) {
    const bf16_t* proj = (const bf16_t*)(F.ws + WS_PROJ); const bf16_t* VT = (const bf16_t*)(F.ws + WS_VT); bf16_t* mix = (bf16_t*)(F.ws + WS_MIX);
    const int lane = F.lane, wid = F.wave, g = wid & 3, s = wid >> 2, r32 = lane & 31, hi = lane >> 5;
    LAS unsigned char* lds = F.lds;
    const unsigned lds0 = (unsigned)(size_t)lds;
    LAS float* red = (LAS float*)(F.lds + XTRA_OFF);
    gu32* aq = F.ctl + CW_ATTQ; const int myq = (F.vcu * 8) / F.G; int qk = 0, ndone = 0;
    LAS int* qslot = (LAS int*)(F.lds + XTRA_OFF + 128);
    LAS float* atab = (LAS float*)(F.lds + XTRA_OFF + 10240);
    { if (F.tid < 128) atab[F.tid] = F.in[I_SUBLN][F.tid];
      else if (F.tid < 192) atab[64 + F.tid] = __uint_as_float(__hip_atomic_load((const unsigned*)(F.ctl + CW_KNMAX) + (F.tid - 128), RLX_AGENT));
      const float a = wave_sum(F.in[I_LQ1][lane] * F.in[I_LK1][lane]), b2 = wave_sum(F.in[I_LQ2][lane] * F.in[I_LK2][lane]);
      if (F.tid == 0) atab[128] = __expf(a) - __expf(b2) + LAMBDA_INIT; }
    if (F.tid == 0) qslot[0] = att_take(aq, myq, qk);
    __syncthreads();
    int unit = qslot[0];
    while (unit >= 0) {
    {
        const int pair = (unit >> 8) * 32 + (unit & 31), h = 7 - ((unit & 255) >> 5), b = pair >> 6, qt = pair & 63, q0 = qt * 128;
        unsigned tkt = 0u;
        if (F.tid == 0 && qk < 8) tkt = __hip_atomic_fetch_add((unsigned*)(aq + ((myq + qk) & 7) * 32), 1u, RLX_AGENT);
    const int ol = opaque(lane);
    int koff[2], voff[2]; unsigned kdst[2], vdst[2];
#pragma unroll
    for (int j = 0; j < 2; ++j) { const int p = 2 * wid + j; const int row = 4 * p + (ol >> 4), c = (ol & 15) ^ (row & 15); koff[j] = (row * PROJ_N + c * 8) * 2;
        const int d = 8 * p + (ol >> 3), cv = (ol & 7) ^ ((d >> 1) & 7); voff[j] = (d * 64 + cv * 8) * 2; kdst[j] = (unsigned)(p * 1024); vdst[j] = (unsigned)(16384 + p * 1024); }
    const int kfo[2] = { pi_swap(ol & 31) * 256, (32 + pi_swap(ol & 31)) * 256 };
    const int krx = pi_swap(ol & 31) & 15;
        const float slope2 = exp2f(-(float)(h + 1)) * LOG2E;
        unsigned bw0;
        { const float x = slope2 * (float)pi_swap(r32); const unsigned xh = f2bf(x); const float xr = x - __uint_as_float(xh << 16); bw0 = hi ? 0u : (xh | (f2bf(xr) << 16)); }
        const bf16_t* qrow = proj + (size_t)(b * SEQ + q0 + 32 * g + r32) * PROJ_N + h * 128 + s * 64 + 8 * hi;
        bf16x8 qf[4]; float qn = 0.f;
        u32x4 qw4[4], kw4[4];
#pragma unroll
        for (int d0 = 0; d0 < 4; ++d0) qw4[d0] = *(const u32x4*)(qrow + 16 * d0);
#pragma unroll
        for (int d0 = 0; d0 < 4; ++d0) kw4[d0] = *(const u32x4*)(qrow + 1024 + 16 * d0);
        __builtin_amdgcn_sched_barrier(0);
#pragma unroll
        for (int d0 = 0; d0 < 4; ++d0) { const u32x4 w = qw4[d0]; qf[d0] = __builtin_bit_cast(bf16x8, w);
#pragma unroll
            for (int j = 0; j < 4; ++j) qn += bflo(w[j]) * bflo(w[j]) + bfhi(w[j]) * bfhi(w[j]); }
        qn += __shfl_xor(qn, 32); qn = wave_max(qn);
        float sself = 0.f;
#pragma unroll
        for (int d0 = 0; d0 < 4; ++d0) { const u32x4 kw = kw4[d0]; const u32x4 qw = qw4[d0];
#pragma unroll
            for (int j = 0; j < 4; ++j) sself += bflo(kw[j]) * bflo(qw[j]) + bfhi(kw[j]) * bfhi(qw[j]); }
        sself += __shfl_xor(sself, 32); const float srow = sself; sself = -wave_max(-sself);
        if (lane == 0) { red[wid] = qn; red[8 + wid] = sself; }
        __syncthreads();
        float bnd, ubs;
        { const float k0 = atab[192 + b * 16 + h * 2], k1 = atab[193 + b * 16 + h * 2];
          const float q0m = fmaxf(fmaxf(red[0], red[1]), fmaxf(red[2], red[3])), q1m = fmaxf(fmaxf(red[4], red[5]), fmaxf(red[6], red[7]));
          const float l0 = fminf(fminf(red[8], red[9]), fminf(red[10], red[11])), l1 = fminf(fminf(red[12], red[13]), fminf(red[14], red[15]));
          const float ub0 = sqrtf(q0m * k0), ub1 = sqrtf(q1m * k1); ubs = s ? ub1 : ub0; bnd = fmaxf(ub0 - l0, ub1 - l1); }
        int W = (int)((ATT_THR + bnd) / slope2) + 1; W = __builtin_amdgcn_readfirstlane(W);
        int kv_lo = q0 - W; kv_lo = kv_lo < 0 ? 0 : (kv_lo & ~63);
        int kv_hi = q0 + 128 + W; kv_hi = kv_hi > SEQ ? SEQ : ((kv_hi + 63) & ~63);
        const int ntile = (kv_hi - kv_lo) >> 6;
        const bf16_t* kg0 = proj + (size_t)(b * SEQ + kv_lo) * PROJ_N + 1024 + h * 128;
        const bf16_t* vg0 = VT + (size_t)((b * NH + h) * 128 + (kv_lo >> 6)) * 8192;
#define ATT_DMA(t) do { const unsigned sl_ = lds0 + (unsigned)(((t) & 3) * 32768); _Pragma("unroll") for (int j = 0; j < 2; ++j) { \
            glds16(kg0 + (size_t)(t) * 64 * PROJ_N, (unsigned)koff[j], (unsigned)__builtin_amdgcn_readfirstlane(sl_ + kdst[j])); \
            glds16(vg0 + (size_t)(t) * 8192, (unsigned)voff[j], (unsigned)__builtin_amdgcn_readfirstlane(sl_ + vdst[j])); } } while (0)
        f32x16 o[4]; o[0] = f32x16{}; o[1] = f32x16{}; o[2] = f32x16{}; o[3] = f32x16{};
        const float mref = fmaxf(srow, ubs - 100.0f); float lsum = 0.f;
        const float qpos = (float)(q0 + 32 * g + r32); const int qw0 = q0 + 32 * g;
        f32x16 S[2];
#define ATT_SB() __builtin_amdgcn_sched_barrier(0)
#define ATT_KLD(dst, blk, i) do { const LAS unsigned char* kb_ = lds + ((i) & 3) * 32768; _Pragma("unroll") for (int d0 = 0; d0 < 4; ++d0) dst[d0] = *(const LAS bf16x8*)(kb_ + kfo[blk] + (((s * 8 + 2 * d0 + hi) ^ krx) << 4)); } while (0)
#define ATT_KMM(src, blk) do { f32x16 a_; const float c0_ = -(float)sg[blk] * slope2 * (qpos - (float)(kb0 + 32 * (blk))) - mref; _Pragma("unroll") for (int r = 0; r < 16; ++r) a_[r] = c0_; \
            _Pragma("unroll") for (int d0 = 0; d0 < 4; ++d0) a_ = __builtin_amdgcn_mfma_f32_32x32x16_bf16(src[d0], qf[d0], a_, 0, 0, 0); \
            { u32x4 bf_; bf_.x = sg[blk] == 0 ? 0u : (sg[blk] > 0 ? bw0 : (bw0 ^ 0x80008000u)); bf_.y = 0u; bf_.z = 0u; bf_.w = 0u; u32x4 on_; on_.x = 0x3f803f80u; on_.y = 0u; on_.z = 0u; on_.w = 0u; \
              a_ = __builtin_amdgcn_mfma_f32_32x32x16_bf16(__builtin_bit_cast(bf16x8, bf_), __builtin_bit_cast(bf16x8, on_), a_, 0, 0, 0); } \
            S[blk] = a_; } while (0)
#define ATT_SG(i) const int kb0 = kv_lo + 64 * (i); int sg[2]; _Pragma("unroll") for (int blk = 0; blk < 2; ++blk) { const int kb_ = kb0 + 32 * blk; sg[blk] = (kb_ + 31 < qw0) ? 1 : ((kb_ > qw0 + 31) ? -1 : 0); }
#define ATT_VLD(dst, ks, i) do { const LAS unsigned char* vb_ = lds + (((i) - 1) & 3) * 32768 + 16384; _Pragma("unroll") for (int d = 0; d < 4; ++d) { const int dd_ = 32 * d + r32; dst[d] = *(const LAS bf16x8*)(vb_ + dd_ * 128 + (((2 * (ks) + hi) ^ ((dd_ >> 1) & 7)) << 4)); } } while (0)
#define ATT_BAR(dma) do { if (dma) asm volatile("s_waitcnt vmcnt(4) lgkmcnt(0)\n\ts_barrier" ::: "memory"); else ATT_WAIT_BAR(); } while (0)
#define ATT_SLICE(PN, j) do { const int blk_ = (j) >> 3, r_ = 2 * ((j) & 7); const float s0_ = S[blk_][r_], s1_ = S[blk_][r_ + 1]; \
            const float e0_ = __builtin_amdgcn_exp2f(s0_), e1_ = __builtin_amdgcn_exp2f(s1_); lsa_ += e0_; lsb_ += e1_; PN[(j) >> 2][(j) & 3] = cvt_pk_bf16_c(e0_, e1_); } while (0)
#define ATT_MIDBIAS(i) do { const float dq_ = qpos - (float)(kv_lo + (i) * 64 + 8 * hi); _Pragma("unroll") for (int blk = 0; blk < 2; ++blk) { if (sg[blk] == 0) { \
            _Pragma("unroll") for (int r = 0; r < 16; ++r) { const float tt_ = dq_ - (float)(32 * blk + 16 * (r >> 3) + (r & 7)); S[blk][r] = S[blk][r] - slope2 * fabsf(tt_); } } } } while (0)
#define ATT_FINAL() do { lsum += lsa_ + lsb_; } while (0)
#define ATT_PVG(PC, g) do { _Pragma("unroll") for (int d = 0; d < 4; ++d) o[d] = __builtin_amdgcn_mfma_f32_32x32x16_bf16(va[d], __builtin_bit_cast(bf16x8, PC[g]), o[d], 0, 0, 0); } while (0)
#define ATT_ITER(i, PC, PN, HASPV) do { const bool dma = ((i) + 2 < ntile); if (dma && !(HASPV)) ATT_DMA((i) + 2); \
            ATT_SG(i); bf16x8 va[4], vb[4]; float lsa_ = 0.f, lsb_ = 0.f; \
            __builtin_amdgcn_s_setprio(1); \
            ATT_KLD(va, 0, i); ATT_KLD(vb, 1, i); ATT_SB(); ATT_KMM(va, 0); ATT_SB(); if (HASPV) { ATT_VLD(va, 0, i); ATT_SB(); } ATT_KMM(vb, 1); ATT_SB(); \
            __builtin_amdgcn_s_setprio(0); \
            ATT_MIDBIAS(i); ATT_SB(); \
            _Pragma("unroll") for (int g = 0; g < 4; ++g) { \
                _Pragma("unroll") for (int d = 0; d < 4; ++d) { if (HASPV) { o[d] = __builtin_amdgcn_mfma_f32_32x32x16_bf16(va[d], __builtin_bit_cast(bf16x8, PC[g]), o[d], 0, 0, 0); \
                          \
                        if (d >= 1 && g < 3) { const int dd_ = 32 * (d - 1) + r32; va[d - 1] = *(const LAS bf16x8*)(lds + (((i) - 1) & 3) * 32768 + 16384 + dd_ * 128 + (((2 * (g + 1) + hi) ^ ((dd_ >> 1) & 7)) << 4)); } \
                        if (d == 0 && g >= 1) { const int dd_ = 32 * 3 + r32; va[3] = *(const LAS bf16x8*)(lds + (((i) - 1) & 3) * 32768 + 16384 + dd_ * 128 + (((2 * g + hi) ^ ((dd_ >> 1) & 7)) << 4)); } } \
                    ATT_SLICE(PN, 4 * g + d); ATT_SB(); } \
                if ((HASPV) && dma) { const unsigned sl_ = lds0 + (unsigned)((((i) + 2) & 3) * 32768);     \
                    if (g & 1) glds16(vg0 + (size_t)((i) + 2) * 8192, (unsigned)voff[g >> 1], (unsigned)__builtin_amdgcn_readfirstlane(sl_ + vdst[g >> 1])); \
                    else glds16(kg0 + (size_t)((i) + 2) * 64 * PROJ_N, (unsigned)koff[g >> 1], (unsigned)__builtin_amdgcn_readfirstlane(sl_ + kdst[g >> 1])); } } \
            ATT_FINAL(); ATT_BAR(dma); } while (0)
#define ATT_DRAIN(PC) do { bf16x8 va[4]; \
            _Pragma("unroll") for (int g = 0; g < 4; ++g) { ATT_VLD(va, g, ntile); ATT_SB(); ATT_PVG(PC, g); ATT_SB(); } \
            } while (0)
        u32x4 pA[4], pB[4];
        ATT_DMA(0); if (ntile > 1) ATT_DMA(1);
        ATT_WAIT_BAR();
        ATT_ITER(0, pB, pA, false);
        for (int i = 1; i < ntile; i += 2) {
            ATT_ITER(i, pA, pB, true);
            if (i + 1 < ntile) ATT_ITER(i + 1, pB, pA, true);
        }
        if ((ntile - 1) & 1) ATT_DRAIN(pB); else ATT_DRAIN(pA);
#undef ATT_SB
#undef ATT_KLD
#undef ATT_KMM
#undef ATT_SG
#undef ATT_VLD
#undef ATT_BAR
#undef ATT_SLICE
#undef ATT_MIDBIAS
#undef ATT_FINAL
#undef ATT_ITER
#undef ATT_DRAIN
#undef ATT_PVG
        __syncthreads();
#undef ATT_DMA
        lsum += __shfl_xor(lsum, 32);
        const float lam = atab[128];
        const float inv = (s == 0 ? 1.0f : lam) / lsum;
        LAS float* cb = (LAS float*)lds + g * 4096;
        if (s == 1) {
#pragma unroll
            for (int d = 0; d < 4; ++d)
#pragma unroll
                for (int r = 0; r < 16; ++r) cb[(d * 16 + r) * 64 + lane] = o[d][r] * inv;
        }
        __syncthreads();
        if (s == 0) {
            float ss = 0.f;
#pragma unroll
            for (int d = 0; d < 4; ++d) {
#pragma unroll
                for (int r = 0; r < 16; ++r) { const float v = o[d][r] * inv - cb[(d * 16 + r) * 64 + lane]; o[d][r] = v; ss += v * v; }
                __builtin_amdgcn_sched_barrier(0); }
            ss += __shfl_xor(ss, 32);
            const float rs = rsqrtf(ss * (1.0f / 128.0f) + LN_EPS) * (1.0f - LAMBDA_INIT);
            const LAS float* sw = atab;
            bf16_t* orow = mix + (size_t)(b * SEQ + q0 + 32 * g + r32) * DM + h * 128;
#pragma unroll
            for (int d = 0; d < 4; ++d) {
                u32x2 w[4];
#pragma unroll
                for (int rq = 0; rq < 4; ++rq) { const int dcol = 32 * d + 8 * rq + 4 * hi; const f32x4 wv = *(const LAS f32x4*)(sw + dcol);
                    w[rq].x = cvt_pk_bf16_c(o[d][4 * rq + 0] * rs * wv[0], o[d][4 * rq + 1] * rs * wv[1]); w[rq].y = cvt_pk_bf16_c(o[d][4 * rq + 2] * rs * wv[2], o[d][4 * rq + 3] * rs * wv[3]); }
#pragma unroll
                for (int rp = 0; rp < 2; ++rp) { const auto sx = __builtin_amdgcn_permlane32_swap(w[2 * rp].x, w[2 * rp + 1].x, false, false), sy = __builtin_amdgcn_permlane32_swap(w[2 * rp].y, w[2 * rp + 1].y, false, false);
                    u32x4 q4; q4.x = sx[0]; q4.y = sy[0]; q4.z = sx[1]; q4.w = sy[1];
                    *(u32x4*)(orow + 32 * d + 8 * (2 * rp + hi)) = q4; }
                __builtin_amdgcn_sched_barrier(0); }
        }
        if (F.tid == 0) { int nx = -1; if (qk < 8) { if (tkt < 256u) nx = ((myq + qk) & 7) * 256 + (int)tkt; else { ++qk; nx = att_take(aq, myq, qk); } } qslot[0] = nx; }
    }
    __syncthreads();
    unit = qslot[0];
    if (ndone++ == 0) after_first();
    }
    if (ndone == 0) after_first();
}

__device__ __forceinline__ void ln_rows(Frame& F, const bf16_t* z, const float* gam, const float* bet, unsigned char* oq, float* stats, int wg0) {
    const int gw = (F.vcu - wg0) * NWAVES + F.wave, NGW = (F.G - wg0) * NWAVES, lane = F.lane;
    for (int m = gw; m < NTOK; m += NGW) {
        const GAS u32x4* zr = (const GAS u32x4*)(z + (size_t)m * DM) + lane;
        f32x4 v[8]; float s = 0.f;
#pragma unroll
        for (int j = 0; j < 4; ++j) { const u32x4 r = zr[64 * j]; v[2 * j] = f32x4{bflo(r.x), bfhi(r.x), bflo(r.y), bfhi(r.y)}; v[2 * j + 1] = f32x4{bflo(r.z), bfhi(r.z), bflo(r.w), bfhi(r.w)};
            s += ((v[2 * j].x + v[2 * j].y) + (v[2 * j].z + v[2 * j].w)) + ((v[2 * j + 1].x + v[2 * j + 1].y) + (v[2 * j + 1].z + v[2 * j + 1].w)); }
        const float mean = wave_sum(s) * (1.f / DM); float s2 = 0.f;
#pragma unroll
        for (int j = 0; j < 8; ++j) { v[j] = v[j] - mean; s2 += (v[j].x * v[j].x + v[j].y * v[j].y) + (v[j].z * v[j].z + v[j].w * v[j].w); }
        const float rstd = rsqrtf(wave_sum(s2) * (1.f / DM) + LN_EPS);
        if (lane == 0) { stats[2 * m] = mean; stats[2 * m + 1] = rstd; }
        GAS u32x2* o8 = (GAS u32x2*)(oq + (size_t)m * DM) + lane;
#pragma unroll
        for (int j = 0; j < 4; ++j) { const f32x4 g0 = *((const f32x4*)gam + 2 * (lane + 64 * j)), g1 = *((const f32x4*)gam + 2 * (lane + 64 * j) + 1), b0 = *((const f32x4*)bet + 2 * (lane + 64 * j)), b1 = *((const f32x4*)bet + 2 * (lane + 64 * j) + 1);
            const f32x4 y0 = v[2 * j] * rstd * g0 + b0, y1 = v[2 * j + 1] * rstd * g1 + b1;
            int p0 = __builtin_amdgcn_cvt_pk_fp8_f32(y0.x, y0.y, 0, false); p0 = __builtin_amdgcn_cvt_pk_fp8_f32(y0.z, y0.w, p0, true);
            int p1 = __builtin_amdgcn_cvt_pk_fp8_f32(y1.x, y1.y, 0, false); p1 = __builtin_amdgcn_cvt_pk_fp8_f32(y1.z, y1.w, p1, true);
            u32x2 w; w.x = (unsigned)p0; w.y = (unsigned)p1; o8[64 * j] = w; }
    }
}

struct ProbMV {
    static constexpr bool META = false, GATHER = false, FP8 = true;
    int Kb, lda, ldb, G, c;
    const unsigned char *kmem, *vmem, *wqn, *wo8;
    __device__ __forceinline__ bool next(int i, pg8::Unit& u) const { const int L = i * G + c; if (L >= 256) return false; u.g = L >> 7; u.pm = (L >> 3) & 15; u.pn = L & 7; return true; }
    __device__ __forceinline__ const char* a_base(const pg8::Unit& u) const { return (const char*)(u.g == 0 ? kmem + (size_t)((u.pm >> 2) * NMEM) * DM + (u.pm & 3) * MHD : wo8 + (size_t)(u.pn * 256) * DM + (u.pm & 3) * MHD); }
    __device__ __forceinline__ const char* b_base(const pg8::Unit& u) const { return (const char*)(u.g == 0 ? wqn + (size_t)(u.pn * 256) * DM + (u.pm & 3) * MHD : vmem + (size_t)((u.pm >> 2) * NMEM) * DM + (u.pm & 3) * MHD); }
};
struct EpiMV {
    static constexpr bool PERM = true;
    unsigned char *MT, *VWT;
    __device__ __forceinline__ void operator()(const pg8::Acc& acc, const pg8::Unit& u, int wr, int wc, int fr, int fq) const {
        if (u.g == 0) pg8::store_tile_fp8(acc, MT + (size_t)((u.pm >> 2) * 1024 + (u.pm & 3) * 256) * DM + u.pn * 256, DM, 1.0f / M8_DIV, wr, wc, fr, fq);
        else pg8::store_tile_fp8(acc, VWT + (size_t)((u.pm >> 2) * DM + u.pn * 256) * 1024 + (u.pm & 3) * 256, 1024, 1.0f / VW8_DIV, wr, wc, fr, fq); }
};
struct ProbScores {
    static constexpr bool META = false, GATHER = false, FP8 = true;
    int Kb, lda, ldb, G, c;
    const unsigned char *x1q, *MT;
    __device__ __forceinline__ bool next(int i, pg8::Unit& u) const { const int L = i * G + c; if (L >= 512) return false; const int w = pg8::xcd_chunk(L, 512); u.g = w >> 5; u.pm = w & 31; u.pn = 0; return true; }
    __device__ __forceinline__ const char* a_base(const pg8::Unit& u) const { return (const char*)(x1q + (size_t)((u.g >> 2) * SEQ + u.pm * 256) * DM); }
    __device__ __forceinline__ const char* b_base(const pg8::Unit& u) const { return (const char*)(MT + (size_t)((u.g >> 2) * 1024 + (u.g & 3) * 256) * DM); }
};
struct EpiSoftmax {
    static constexpr bool PERM = true;
    unsigned char* Pm; LAS float* PM; LAS float* PS;
    __device__ __forceinline__ void operator()(pg8::Acc& acc, const pg8::Unit& u, int wr, int wc, int fr_, int fq) const {
        const int fr = opaque(fr_);
        constexpr float SSCALE = MQSCALE * M8_DIV / WQ8_SCALE;
#pragma unroll
        for (int ai = 0; ai < 2; ++ai)
#pragma unroll
            for (int m = 0; m < 4; ++m) { float x = -INFINITY;
#pragma unroll
                for (int bj = 0; bj < 2; ++bj)
#pragma unroll
                    for (int n = 0; n < 2; ++n) { const f32x4 v = acc[ai][bj][m][n] * SSCALE; acc[ai][bj][m][n] = v; x = fmaxf(fmaxf(x, fmaxf(v[0], v[1])), fmaxf(v[2], v[3])); }
                x = fmaxf(x, __shfl_xor(x, 16)); x = fmaxf(x, __shfl_xor(x, 32));
                if (fq == 0) PM[(ai * 128 + wr * 64 + m * 16 + fr) * 4 + wc] = x; }
        asm volatile("s_waitcnt lgkmcnt(0)" ::: "memory"); __builtin_amdgcn_s_barrier(); asm volatile("" ::: "memory");
#pragma unroll
        for (int ai = 0; ai < 2; ++ai)
#pragma unroll
            for (int m = 0; m < 4; ++m) { const f32x4 q = *(const LAS f32x4*)(PM + (ai * 128 + wr * 64 + m * 16 + fr) * 4); const float mxr = fmaxf(fmaxf(q[0], q[1]), fmaxf(q[2], q[3])); float sm = 0.f;
#pragma unroll
                for (int bj = 0; bj < 2; ++bj)
#pragma unroll
                    for (int n = 0; n < 2; ++n) { f32x4 v = acc[ai][bj][m][n];
#pragma unroll
                        for (int e = 0; e < 4; ++e) { v[e] = __builtin_amdgcn_exp2f(v[e] - mxr); sm += v[e]; }
                        acc[ai][bj][m][n] = v; }
                sm += __shfl_xor(sm, 16); sm += __shfl_xor(sm, 32);
                if (fq == 0) PS[(ai * 128 + wr * 64 + m * 16 + fr) * 4 + wc] = sm; }
        asm volatile("s_waitcnt lgkmcnt(0)" ::: "memory"); __builtin_amdgcn_s_barrier(); asm volatile("" ::: "memory");
        unsigned char* O = Pm + (size_t)((u.g >> 2) * SEQ + u.pm * 256) * 1024 + (u.g & 3) * 256;
#pragma unroll
        for (int ai = 0; ai < 2; ++ai)
#pragma unroll
            for (int m = 0; m < 4; ++m) { const f32x4 q = *(const LAS f32x4*)(PS + (ai * 128 + wr * 64 + m * 16 + fr) * 4); const float inv = P8_SCALE / ((q[0] + q[1]) + (q[2] + q[3]));
                unsigned char* rowp = O + (size_t)(ai * 128 + wr * 64 + m * 16 + fr) * 1024 + wc * 32 + ((fq & 1) ? 128 + 8 * (fq - 1) : 8 * fq);
                *(u32x4*)rowp = pg8::pair16(pg8::pack8_fp8(acc[ai][0][m][0] * inv, acc[ai][0][m][1] * inv), pg8::pack8_fp8(acc[ai][1][m][0] * inv, acc[ai][1][m][1] * inv)); }
    }
};
struct ProbOutQ {
    static constexpr bool META = false, GATHER = false, FP8 = true;
    int Kb, lda, ldb, G, c;
    const unsigned char *P8, *VWT;
    __device__ __forceinline__ bool next(int i, pg8::Unit& u) const { const int L = i * G + c; if (L >= 1024) return false; u.g = 0; pg8::tile_of(pg8::xcd_chunk(L, 1024), 128, 8, 8, u.pm, u.pn); return true; }
    __device__ __forceinline__ const char* a_base(const pg8::Unit& u) const { return (const char*)(P8 + (size_t)u.pm * 256 * 1024); }
    __device__ __forceinline__ const char* b_base(const pg8::Unit& u) const { return (const char*)(VWT + (size_t)((u.pm >> 5) * DM + u.pn * 256) * 1024); }
};

__device__ __forceinline__ void p_ln2_router(Frame& F) {
    const bf16_t* z2 = (const bf16_t*)(F.ws + WS_Z); const bf16_t* rt = (const bf16_t*)(F.ws + WS_ROUTT);
    const float* gam = F.in[I_LN2G]; const float* bet = F.in[I_LN2B]; float* stats = (float*)(F.ws + WS_STAT2); unsigned char* xq = F.ws + WS_R1;
    int* eltok = (int*)(F.ws + WS_ELTOK); float* elgate = (float*)(F.ws + WS_ELGATE); int* tokslot = (int*)(F.ws + WS_TOKSLOT);
    LAS float* lg = (LAS float*)(F.lds) + F.wave * 512;
    LAS float* st = (LAS float*)(F.lds + 16384) + F.wave * 32;
    LAS int* lcnt = (LAS int*)(F.lds + XTRA_OFF);
    const int lane = F.lane, r16 = lane & 15, kq = lane >> 4;
    for (int blk = F.vcu; blk < NTOK / 128; blk += F.G) {
        __syncthreads();
        if (F.tid < 64) lcnt[F.tid] = 0;
        __syncthreads();
        const int tok0 = blk * 128 + F.wave * 16;
        for (int j = 0; j < 16; ++j) { const int m = tok0 + j;
            const GAS u32x4* zr = (const GAS u32x4*)(z2 + (size_t)m * DM) + lane;
            f32x4 v[8]; float s = 0.f;
#pragma unroll
            for (int q = 0; q < 4; ++q) { const u32x4 r = zr[64 * q]; v[2 * q] = f32x4{bflo(r.x), bfhi(r.x), bflo(r.y), bfhi(r.y)}; v[2 * q + 1] = f32x4{bflo(r.z), bfhi(r.z), bflo(r.w), bfhi(r.w)};
                s += ((v[2 * q].x + v[2 * q].y) + (v[2 * q].z + v[2 * q].w)) + ((v[2 * q + 1].x + v[2 * q + 1].y) + (v[2 * q + 1].z + v[2 * q + 1].w)); }
            const float mean = wave_sum(s) * (1.f / DM); float s2 = 0.f;
#pragma unroll
            for (int q = 0; q < 8; ++q) { v[q] = v[q] - mean; s2 += (v[q].x * v[q].x + v[q].y * v[q].y) + (v[q].z * v[q].z + v[q].w * v[q].w); }
            const float rstd = rsqrtf(wave_sum(s2) * (1.f / DM) + LN_EPS);
            if (lane == 0) { stats[2 * m] = mean; stats[2 * m + 1] = rstd; st[2 * j] = mean; st[2 * j + 1] = rstd; }
            GAS u32x2* o8 = (GAS u32x2*)(xq + (size_t)m * DM) + lane;
#pragma unroll
            for (int q = 0; q < 4; ++q) { const f32x4 g0 = *((const f32x4*)gam + 2 * (lane + 64 * q)), g1 = *((const f32x4*)gam + 2 * (lane + 64 * q) + 1), b0 = *((const f32x4*)bet + 2 * (lane + 64 * q)), b1 = *((const f32x4*)bet + 2 * (lane + 64 * q) + 1);
                const f32x4 y0 = v[2 * q] * rstd * g0 + b0, y1 = v[2 * q + 1] * rstd * g1 + b1;
                int p0 = __builtin_amdgcn_cvt_pk_fp8_f32(y0.x, y0.y, 0, false); p0 = __builtin_amdgcn_cvt_pk_fp8_f32(y0.z, y0.w, p0, true);
                int p1 = __builtin_amdgcn_cvt_pk_fp8_f32(y1.x, y1.y, 0, false); p1 = __builtin_amdgcn_cvt_pk_fp8_f32(y1.z, y1.w, p1, true);
                u32x2 w; w.x = (unsigned)p0; w.y = (unsigned)p1; o8[64 * q] = w; }
        }
        LDS_WAIT(); asm volatile("" ::: "memory");
        f32x4 a0 = {0.f, 0.f, 0.f, 0.f}, a1 = a0;
        {
            const bf16_t* xr = z2 + (size_t)(tok0 + r16) * DM + 8 * kq; const bf16_t* w0 = rt + (size_t)r16 * DM + 8 * kq; const bf16_t* w1 = rt + (size_t)(r16 + 16) * DM + 8 * kq;
            constexpr int LO = 32 * 2048;
            u32x4 zb[4], wa[4][2], wb[4][2];
#pragma unroll
            for (int u = 0; u < 4; ++u) { zb[u] = *(const u32x4*)(xr + 32 * u); wa[u][0] = *(const u32x4*)(w0 + 32 * u); wa[u][1] = *(const u32x4*)(w0 + LO + 32 * u); wb[u][0] = *(const u32x4*)(w1 + 32 * u); wb[u][1] = *(const u32x4*)(w1 + LO + 32 * u); }
#pragma unroll 1
            for (int j0 = 0; j0 < DM / 32; j0 += 4) {
#pragma unroll
                for (int u = 0; u < 4; ++u) {
                    const bf16x8 zz = __builtin_bit_cast(bf16x8, zb[u]), ah = __builtin_bit_cast(bf16x8, wa[u][0]), al = __builtin_bit_cast(bf16x8, wa[u][1]), bh = __builtin_bit_cast(bf16x8, wb[u][0]), bl = __builtin_bit_cast(bf16x8, wb[u][1]);
                    const int jn = (j0 + u + 4 < DM / 32) ? j0 + u + 4 : DM / 32 - 1;
                    zb[u] = *(const u32x4*)(xr + 32 * jn); wa[u][0] = *(const u32x4*)(w0 + 32 * jn); wa[u][1] = *(const u32x4*)(w0 + LO + 32 * jn); wb[u][0] = *(const u32x4*)(w1 + 32 * jn); wb[u][1] = *(const u32x4*)(w1 + LO + 32 * jn);
                    __builtin_amdgcn_sched_barrier(0);
                    a0 = __builtin_amdgcn_mfma_f32_16x16x32_bf16(zz, ah, a0, 0, 0, 0); a1 = __builtin_amdgcn_mfma_f32_16x16x32_bf16(zz, bh, a1, 0, 0, 0);
                    a0 = __builtin_amdgcn_mfma_f32_16x16x32_bf16(zz, al, a0, 0, 0, 0); a1 = __builtin_amdgcn_mfma_f32_16x16x32_bf16(zz, bl, a1, 0, 0, 0);
                    __builtin_amdgcn_sched_barrier(0);
                }
            }
        }
        { const float* rc = (const float*)(F.ctl) + CW_RC; const float c1a = rc[r16], c1b = rc[16 + r16], c2a = rc[32 + r16], c2b = rc[48 + r16];
#pragma unroll
          for (int j = 0; j < 4; ++j) { const float mu = st[2 * (4 * kq + j)], rs = st[2 * (4 * kq + j) + 1];
              lg[(4 * kq + j) * 32 + r16] = (a0[j] - mu * c1a) * rs + c2a; lg[(4 * kq + j) * 32 + 16 + r16] = (a1[j] - mu * c1b) * rs + c2b; } }
        LDS_WAIT(); asm volatile("" ::: "memory");
        int es[4], rk[4]; float gs[4];
        if (lane < 16) {
            float v[32];
#pragma unroll
            for (int e = 0; e < 32; ++e) v[e] = lg[lane * 32 + e];
            float tv[4];
#pragma unroll
            for (int k = 0; k < 4; ++k) { float best = -INFINITY; int bi = 0;
#pragma unroll
                for (int e = 0; e < 32; ++e) { if (v[e] > best) { best = v[e]; bi = e; } }
                tv[k] = best; es[k] = bi;
#pragma unroll
                for (int e = 0; e < 32; ++e) if (e == bi) v[e] = -INFINITY; }
            const float e1 = __expf(tv[1] - tv[0]), e2 = __expf(tv[2] - tv[0]), e3 = __expf(tv[3] - tv[0]); const float inv = 1.0f / (1.0f + e1 + e2 + e3);
            gs[0] = inv; gs[1] = e1 * inv; gs[2] = e2 * inv; gs[3] = e3 * inv;
#pragma unroll
            for (int k = 0; k < 4; ++k) rk[k] = __hip_atomic_fetch_add(&lcnt[es[k]], 1, __ATOMIC_RELAXED, __HIP_MEMORY_SCOPE_WORKGROUP);
        }
        __syncthreads();
        if (F.tid < 32) lcnt[32 + F.tid] = (int)__hip_atomic_fetch_add((unsigned*)(F.ctl + CW_ECNT) + F.tid, (unsigned)lcnt[F.tid], RLX_AGENT);
        __syncthreads();
        if (lane < 16) { const int tok = tok0 + lane;
#pragma unroll
            for (int k = 0; k < 4; ++k) { const int pos = lcnt[32 + es[k]] + rk[k]; eltok[es[k] * NTOK + pos] = tok; elgate[es[k] * NTOK + pos] = gs[k]; tokslot[tok * 4 + k] = (es[k] << 16) | pos; } }
    }
    __syncthreads();
}

struct ESched { LAS int* tb; };
__device__ __forceinline__ void build_esched(Frame& F, LAS int* tb, int nN) {
    __syncthreads();
    if (F.tid < 64) { const int e = F.lane & 31; const int c = (int)__hip_atomic_load((unsigned*)(F.ctl + CW_ECNT) + e, RLX_AGENT);
        int rs = 0, us = 0, uc = 0;
        for (int j = 0; j < 32; ++j) { const int cj = __shfl(c, j); if (j < e) { rs += (cj + 31) & ~31; us += ((cj + 127) >> 8) * nN; uc += (((cj + 255) >> 8) - ((cj + 127) >> 8)) * nN; } }
        if (F.lane < 32) { tb[e] = c; tb[32 + e] = rs; tb[65 + e] = us; tb[98 + e] = uc; if (e == 31) { tb[64] = rs + ((c + 31) & ~31); tb[97] = us + ((c + 127) >> 8) * nN; tb[130] = uc + (((c + 255) >> 8) - ((c + 127) >> 8)) * nN; } } }
    __syncthreads();
}
template <int NN, bool GATH> struct ProbExpert {
    static constexpr bool META = true, GATHER = GATH, FP8 = true;
    int Kb, lda, ldb, G, c;
    LAS int* tb; const unsigned char* A; const unsigned char* W; size_t wstride;
    const void* listA;
    const float* b0; const float* b1;
    LAS unsigned char* meta;
    __device__ __forceinline__ int rd(int i) const { return __builtin_amdgcn_readfirstlane(tb[i]); }
    __device__ __forceinline__ bool next(int i, pg8::Unit& u) const {
        if (i >= 128) return false;
        const LAS int* p = tb + 256 + i * 8; const v4i32 a = *(const LAS v4i32*)p; const int r4 = p[4], r5 = p[5];
        u.g = __builtin_amdgcn_readfirstlane(a[0]); u.pm = __builtin_amdgcn_readfirstlane(a[1]); u.pn = __builtin_amdgcn_readfirstlane(a[2]); u.rs = __builtin_amdgcn_readfirstlane(r4); u.cnt = __builtin_amdgcn_readfirstlane(r5);
        return u.g >= 0; }
    __device__ __forceinline__ void table_entry(int i, LAS int* ent) const {
        const int L = i * G + c, nfull = tb[97]; int e = -1, pm = 0, pn = 0;
        if (L < nfull + tb[130]) {
            const bool shrt = L >= nfull; const int w = shrt ? L - nfull : pg8::xcd_chunk(L, nfull), t0 = shrt ? 98 : 65;
            e = 0;
#pragma unroll
            for (int st = 16; st >= 1; st >>= 1) if (tb[t0 + e + st] <= w) e += st;
            const int loc = w - tb[t0 + e], nF = (tb[e] + 127) >> 8;
            if (shrt) { pm = nF; pn = loc; } else pg8::tile_of(loc, nF, NN, 4, pm, pn); }
        const int cn = e >= 0 ? tb[e] : 0;
        ent[0] = e; ent[1] = pm; ent[2] = pn; ent[3] = (cn - pm * 256 <= 128) ? 1 : 0; ent[4] = e >= 0 ? tb[32 + e] : 0; ent[5] = cn; ent[6] = 0; ent[7] = 0; }
    __device__ __forceinline__ bool lower_only(const pg8::Unit& u) const { return u.cnt - u.pm * 256 <= 128; }
    __device__ __forceinline__ const char* a_base(const pg8::Unit& u) const { if constexpr (GATH) return (const char*)A; else return (const char*)(A + (size_t)(u.rs + u.pm * 256) * lda); }
    __device__ __forceinline__ const char* b_base(const pg8::Unit& u) const { return (const char*)(W + (size_t)u.g * wstride + (size_t)u.pn * 256 * ldb); }
    __device__ __forceinline__ void meta_prefetch(const pg8::Unit& u, int slot, int wid, int lane) const {
        if (wid == 0) { const unsigned dst = (unsigned)(size_t)(meta + slot * 2048);
            glds16v((const char*)listA + ((size_t)u.g * NTOK + (size_t)u.pm * 256) * 4 + lane * 16, dst);
            const float* src; if constexpr (GATH) src = (lane < 32 ? b0 : b1) + (size_t)u.g * FF + u.pn * 128 + (lane & 31) * 4; else src = b0 + (size_t)u.g * DM + u.pn * 256 + lane * 4;
            glds16v(src, dst + 1024u); }
    }
    __device__ __forceinline__ void a_rows(const pg8::Unit& u, int slot, const int (&Rl)[2], const int (&Cl)[2], unsigned (&voff)[2][2]) const {
        const int cnt = u.cnt; const LAS int* idx = (const LAS int*)(meta + slot * 2048);
#pragma unroll
        for (int h = 0; h < 2; ++h)
#pragma unroll
            for (int i = 0; i < 2; ++i) { const int r = h * 128 + Rl[i]; const int tok = (u.pm * 256 + r < cnt) ? idx[r] : 0;
                voff[h][i] = (unsigned)tok * (unsigned)lda + (unsigned)Cl[i] * 2u; }
    }
};
namespace pg8 { template <> struct a_blocked<ProbExpert<8, false>> { static constexpr bool value = true; }; }
struct EpiSwiGLU {
    static constexpr bool PERM = true;
    LAS int* tb; unsigned char* H; LAS unsigned char* meta;
    __device__ __forceinline__ u32x2 row8(const pg8::Acc& acc, int ai, int m, const f32x4& g0, const f32x4& g1, const f32x4& u0, const f32x4& u1) const {
        constexpr float CG = SW_ALPHA * LOG2E;
        f32x4 ga = acc[ai][0][m][0] * (CG / WG_SCALE) + g0, gb = acc[ai][0][m][1] * (CG / WG_SCALE) + g1, ua = acc[ai][1][m][0] * (1.0f / (CG * WG_SCALE)) + u0, ub = acc[ai][1][m][1] * (1.0f / (CG * WG_SCALE)) + u1; f32x4 h0, h1;
#pragma unroll
        for (int j = 0; j < 4; ++j) { const float gg = fminf(ga[j], CG * SW_LIMIT), uu = __builtin_amdgcn_fmed3f(ua[j], (1.0f - SW_LIMIT) / CG, (1.0f + SW_LIMIT) / CG); h0[j] = gg * __builtin_amdgcn_rcpf(1.0f + __builtin_amdgcn_exp2f(-gg)) * uu;
            const float g2 = fminf(gb[j], CG * SW_LIMIT), u2 = __builtin_amdgcn_fmed3f(ub[j], (1.0f - SW_LIMIT) / CG, (1.0f + SW_LIMIT) / CG); h1[j] = g2 * __builtin_amdgcn_rcpf(1.0f + __builtin_amdgcn_exp2f(-g2)) * u2; }
        return pg8::pack8_fp8(h0, h1); }
    __device__ __forceinline__ void operator()(const pg8::Acc& acc, const pg8::Unit& u, int wr, int wc, int fr_, int fq, int slot) const {
        const int fr = opaque(fr_);
        const int cnt = u.cnt, rs = u.rs;
        const int cpart = u.pn * 4096 + wc * 1024 + (fq >> 1) * 16;
        const LAS float* mb = (const LAS float*)(meta + slot * 2048 + 1024) + wc * 32 + 8 * fq;
        constexpr float CGb = SW_ALPHA * LOG2E;
        const f32x4 g0 = *(const LAS f32x4*)(mb) * CGb, g1 = *(const LAS f32x4*)(mb + 4) * CGb, u0 = (*(const LAS f32x4*)(mb + 128) + 1.0f) * (1.0f / CGb), u1 = (*(const LAS f32x4*)(mb + 132) + 1.0f) * (1.0f / CGb);
#pragma unroll
        for (int ai = 0; ai < 2; ++ai)
#pragma unroll
            for (int m = 0; m < 4; m += 2) { const int r = u.pm * 256 + ai * 128 + wr * 64 + (m + (fq & 1)) * 16 + fr;
                const u32x4 q = pg8::pair16(row8(acc, ai, m, g0, g1, u0, u1), row8(acc, ai, m + 1, g0, g1, u0, u1));
                if (r < cnt) *(u32x4*)(H + (size_t)(rs + (r & ~31)) * FF + cpart + (r & 31) * 32) = q; }
    }
};
struct EpiDown {
    static constexpr bool PERM = true;
    LAS int* tb; unsigned char* Y; LAS unsigned char* meta;
    __device__ __forceinline__ void operator()(const pg8::Acc& acc, const pg8::Unit& u, int wr, int wc, int fr_, int fq, int slot) const {
        const int fr = opaque(fr_);
        const int cnt = u.cnt, rs = u.rs;
        const int col = u.pn * 256 + wc * 64 + ((fq & 1) ? 32 + 8 * (fq - 1) : 8 * fq);
        f32x4 bv[2][2];
#pragma unroll
        for (int bj = 0; bj < 2; ++bj)
#pragma unroll
            for (int n = 0; n < 2; ++n) bv[bj][n] = *(const LAS f32x4*)((const LAS float*)(meta + slot * 2048 + 1024) + wc * 32 + 8 * fq + bj * 128 + 4 * n);
        float gtv[2][4];
#pragma unroll
        for (int ai = 0; ai < 2; ++ai)
#pragma unroll
            for (int m = 0; m < 4; ++m) gtv[ai][m] = ((const LAS float*)(meta + slot * 2048))[ai * 128 + wr * 64 + m * 16 + fr];
#pragma unroll
        for (int ai = 0; ai < 2; ++ai)
#pragma unroll
            for (int m = 0; m < 4; ++m) { const int r = u.pm * 256 + ai * 128 + wr * 64 + m * 16 + fr; const bool ok = r < cnt; const float gt = gtv[ai][m];
                unsigned char* rowp = Y + (size_t)(rs + r) * DM + col; const float gy = gt * Y_SCALE;
                const u32x4 q = pg8::pair16(pg8::pack8_fp8((acc[ai][0][m][0] * (1.0f / WD_SCALE) + bv[0][0]) * gy, (acc[ai][0][m][1] * (1.0f / WD_SCALE) + bv[0][1]) * gy),
                                            pg8::pack8_fp8((acc[ai][1][m][0] * (1.0f / WD_SCALE) + bv[1][0]) * gy, (acc[ai][1][m][1] * (1.0f / WD_SCALE) + bv[1][1]) * gy));
                if (ok) *(u32x4*)rowp = q; }
    }
};

__device__ __forceinline__ void p_final(Frame& F, LAS int* tb) {
    const int gw = F.vcu * NWAVES + F.wave, NGW = F.G * NWAVES, lane = F.lane;
    const unsigned char* Y = (const unsigned char*)(F.ws + WS_Y); const int* tokslot = (const int*)(F.ws + WS_TOKSLOT);
    const float* gam = F.in[I_LN3G]; const float* bet = F.in[I_LN3B]; const bf16_t* z = (const bf16_t*)(F.ws + WS_Z); float* out = F.out;
    const float* g2 = F.in[I_LN2G]; const float* b2 = F.in[I_LN2B]; const float* stats = (const float*)(F.ws + WS_STAT2);
    int tsn[4];
#pragma unroll
    for (int k = 0; k < 4; ++k) tsn[k] = tokslot[(gw < NTOK ? gw : 0) * 4 + k];
    for (int m = gw; m < NTOK; m += NGW) {
        const float mu2 = stats[2 * m], rs2 = stats[2 * m + 1];
        int slot[4];
#pragma unroll
        for (int k = 0; k < 4; ++k) slot[k] = tb[32 + (tsn[k] >> 16)] + (tsn[k] & 0xffff);
        { const int mn = (m + NGW < NTOK) ? m + NGW : m;
#pragma unroll
          for (int k = 0; k < 4; ++k) tsn[k] = tokslot[mn * 4 + k]; }
        const GAS u32x4* zr = (const GAS u32x4*)(z + (size_t)m * DM) + lane;
        u32x4 zr4[4]; u32x2 yw[4][4];
#pragma unroll
        for (int j = 0; j < 4; ++j) zr4[j] = zr[64 * j];
#pragma unroll
        for (int j = 0; j < 4; ++j) { const int yc = (lane + 64 * j) * 8, yoff = (yc & ~255) + ((yc >> 5) & 3) * 64 + ((yc >> 7) & 1) * 32 + (yc & 31);
#pragma unroll
            for (int k = 0; k < 4; ++k) yw[j][k] = *(const GAS u32x2*)(Y + (size_t)slot[k] * DM + yoff); }
        __builtin_amdgcn_sched_barrier(0);
        f32x4 v[8]; float s = 0.f;
#pragma unroll
        for (int j = 0; j < 4; ++j) { const u32x4 r = zr4[j]; const int c4 = 2 * (lane + 64 * j);
            f32x4 a0 = (((f32x4{bflo(r.x), bfhi(r.x), bflo(r.y), bfhi(r.y)} - mu2) * rs2) * *((const f32x4*)g2 + c4) + *((const f32x4*)b2 + c4)) * ALPHA;
            f32x4 a1 = (((f32x4{bflo(r.z), bfhi(r.z), bflo(r.w), bfhi(r.w)} - mu2) * rs2) * *((const f32x4*)g2 + c4 + 1) + *((const f32x4*)b2 + c4 + 1)) * ALPHA;
#pragma unroll
            for (int k = 0; k < 4; ++k) { const u32x2 w = yw[j][k];
                const auto l0 = __builtin_amdgcn_cvt_pk_f32_fp8((int)w.x, false), h0 = __builtin_amdgcn_cvt_pk_f32_fp8((int)w.x, true), l1 = __builtin_amdgcn_cvt_pk_f32_fp8((int)w.y, false), h1 = __builtin_amdgcn_cvt_pk_f32_fp8((int)w.y, true);
                a0[0] += l0[0] * (1.0f / Y_SCALE); a0[1] += l0[1] * (1.0f / Y_SCALE); a0[2] += h0[0] * (1.0f / Y_SCALE); a0[3] += h0[1] * (1.0f / Y_SCALE);
                a1[0] += l1[0] * (1.0f / Y_SCALE); a1[1] += l1[1] * (1.0f / Y_SCALE); a1[2] += h1[0] * (1.0f / Y_SCALE); a1[3] += h1[1] * (1.0f / Y_SCALE); }
            v[2 * j] = a0; v[2 * j + 1] = a1; s += ((a0.x + a0.y) + (a0.z + a0.w)) + ((a1.x + a1.y) + (a1.z + a1.w)); }
        const float mean = wave_sum(s) * (1.f / DM); float s2 = 0.f;
#pragma unroll
        for (int j = 0; j < 8; ++j) { v[j] = v[j] - mean; s2 += (v[j].x * v[j].x + v[j].y * v[j].y) + (v[j].z * v[j].z + v[j].w * v[j].w); }
        const float rstd = rsqrtf(wave_sum(s2) * (1.f / DM) + LN_EPS);
        GAS f32x4* orow = (GAS f32x4*)(out + (size_t)m * DM);
#pragma unroll
        for (int j = 0; j < 4; ++j) { const int c4 = 2 * (lane + 64 * j);
            v[2 * j] = v[2 * j] * rstd * *((const f32x4*)gam + c4) + *((const f32x4*)bet + c4); v[2 * j + 1] = v[2 * j + 1] * rstd * *((const f32x4*)gam + c4 + 1) + *((const f32x4*)bet + c4 + 1); }
#pragma unroll
        for (int j = 0; j < 4; ++j) { const int c4 = 2 * (lane + 64 * j); orow[c4] = v[2 * j]; orow[c4 + 1] = v[2 * j + 1]; }
    }
}

constexpr int NPHASE = 15;
struct Args { const float* in[27]; float* out; unsigned char* ws; int ph_lo, ph_hi; };
__global__ void __launch_bounds__(NWAVES * 64, 2) mk_fwd(Args args) {
    extern __shared__ __attribute__((aligned(16))) unsigned char lds_raw[];
    Frame F;
    F.lds = (LAS unsigned char*)lds_raw;
    F.tid = threadIdx.x; F.lane = F.tid & 63; F.wave = __builtin_amdgcn_readfirstlane(F.tid >> 6);
    F.G = gridDim.x; { const int bx = blockIdx.x; F.vcu = (F.G % 8 == 0) ? (bx % 8) * (F.G / 8) + bx / 8 : bx; }
    F.ws = args.ws; F.ctl = (gu32*)(args.ws + WS_CTL); F.out = args.out;
#pragma unroll
    for (int i = 0; i < 27; ++i) F.in[i] = args.in[i];
    volatile LAS unsigned* MISC = (volatile LAS unsigned*)(F.lds + MISC_OFF);
    for (int u = F.tid; u < (LDS_BYTES - MISC_OFF) / 4; u += NWAVES * 64) ((LAS unsigned*)(F.lds + MISC_OFF))[u] = 0u;
    __syncthreads();
    const int lo = args.ph_lo, hi = args.ph_hi;
    XcdBarrier bar; bar.bar = (unsigned*)(F.ctl + CW_BAR); bar.x = 0; bar.st = nullptr;
    if (hi - lo > 1) bar = xcd_barrier_post((unsigned*)(F.ctl + CW_BAR), MISC + 8);
#define IN(k) (lo <= (k) && (k) < hi)
#define SEAM(k) do { if (IN(k) && IN((k) + 1)) xcd_barrier(bar); } while (0)
    LAS int* tb = (LAS int*)(F.lds + XTRA_OFF + 8192);
    const int bx = (int)blockIdx.x;

#define REP(k) for (int rep_ = 0; rep_ < (((PROBE_MASK) >> (k)) & 1) + 1; ++rep_)
    if (IN(0)) { REP(0) p0_prologue(F); SEAM(0); }
    if (IN(1)) {
        ProbP1 P{4096, 4096, 4096, F.G, bx, (const bf16_t*)(F.ws + WS_R1), (const bf16_t*)(F.ws + WS_WINA), (const bf16_t*)(F.ws + WS_WINV), (const bf16_t*)(F.ws + WS_WKV), (const bf16_t*)(F.ws + WS_MEMB)};
        EpiP1 E{(bf16_t*)(F.ws + WS_PROJ), (bf16_t*)(F.ws + WS_VT), F.ws + WS_KMEM, F.ws + WS_VMEMT, F.ctl, (LAS float*)(F.lds + XTRA_OFF)};
        CONV_PRE(CONV_K0, CONV_K1);
        REP(1) pg8::gemm_phase<EpiP1, ProbP1, true>(F.lds, P, E);
        CONV_POST(CONV_K0, CONV_K1);
        SEAM(1);
    }
    if (IN(3)) { if (!(F.vcu & 1)) p2_conv<8>(F); CONV_PRE(CONV_K1, CONV_K3); p3_attention(F, [&]() { if (F.vcu & 1) { p2_conv<8>(F); __syncthreads(); p0_conv_range(F, CONV_K1, CONV_K3); __syncthreads(); } });
        SEAM(3); }
    if (IN(4)) {
        ProbDense P{4096, 4096, 4096, F.G, bx, 128, 8, (const bf16_t*)(F.ws + WS_MIX), (const bf16_t*)(F.ws + WS_WOUT)};
        EpiResB E{(const bf16_t*)(F.ws + WS_R1), (bf16_t*)(F.ws + WS_Z)};
        CONV_PRE(CONV_K3, CONV_K4);
        pg8::gemm_phase<EpiResB, ProbDense, true>(F.lds, P, E);
        CONV_POST(CONV_K3, CONV_K4);
        SEAM(4);
    }
    if (IN(5)) {
        if (F.vcu < 64) {
            ProbKV P{4096, 4096, 4096, F.vcu, (const bf16_t*)(F.ws + WS_WKV), (const bf16_t*)(F.ws + WS_MEMB)};
            EpiP1 E{(bf16_t*)(F.ws + WS_PROJ), (bf16_t*)(F.ws + WS_VT), F.ws + WS_KMEM, F.ws + WS_VMEMT, F.ctl, (LAS float*)(F.lds + XTRA_OFF)};
            pg8::gemm_phase<EpiP1, ProbKV, true>(F.lds, P, E);
        } else ln_rows(F, (const bf16_t*)(F.ws + WS_Z), F.in[I_LN1G], F.in[I_LN1B], F.ws + WS_R1, (float*)(F.ws + WS_STAT1), 64);
        SEAM(5);
    }
    if (IN(6)) {
        ProbMV P{512, 2048, 2048, F.G, bx, F.ws + WS_KMEM, F.ws + WS_VMEMT, F.ws + WS_WQ, F.ws + WS_WO};
        EpiMV E{F.ws + WS_MT, F.ws + WS_VWT};
        pg8::gemm_phase<EpiMV, ProbMV, true>(F.lds, P, E);
        SEAM(6);
    }
    if (IN(7)) {
        ProbScores P{2048, 2048, 2048, F.G, bx, F.ws + WS_R1, F.ws + WS_MT};
        EpiSoftmax E{F.ws + WS_P, (LAS float*)(F.lds + XTRA_OFF), (LAS float*)(F.lds + XTRA_OFF + 4096)};
        CONV_PRE(CONV_K4, CONV_K6);
        pg8::gemm_phase<EpiSoftmax, ProbScores, true>(F.lds, P, E);
        CONV_POST(CONV_K4, CONV_K6);
        SEAM(7);
    }
    if (IN(9)) {
        ProbOutQ P{1024, 1024, 1024, F.G, bx, F.ws + WS_P, F.ws + WS_VWT};
        EpiResLNB E{(const bf16_t*)(F.ws + WS_Z), (bf16_t*)(F.ws + WS_Z), (const float*)(F.ws + WS_STAT1), F.in[I_LN1G], F.in[I_LN1B], VW8_DIV / (P8_SCALE * WO8_SCALE)};
        CONV_PRE(CONV_K6, CONV_K9);
        pg8::gemm_phase<EpiResLNB, ProbOutQ, true>(F.lds, P, E);
        CONV_POST(CONV_K6, CONV_K9);
        SEAM(9);
    }
    if (IN(10)) { p_ln2_router(F); SEAM(10); }
    if (IN(12)) {
        build_esched(F, tb, 16);
        ProbExpert<16, true> P{2048, 2048, 2048, F.G, bx, tb, (const unsigned char*)(F.ws + WS_R1), (const unsigned char*)(F.ws + WS_WGU), (size_t)4096 * 2048, (const void*)(F.ws + WS_ELTOK), F.in[I_BG], F.in[I_BU], F.lds + XTRA_OFF};
        if (F.tid < 128) P.table_entry(F.tid, tb + 256 + F.tid * 8);
        __syncthreads();
        EpiSwiGLU E{tb, (unsigned char*)(F.ws + WS_H), F.lds + XTRA_OFF};
        REP(12) pg8::gemm_phase<EpiSwiGLU, ProbExpert<16, true>, true>(F.lds, P, E);
        SEAM(12);
    }
    if (IN(13)) {
        build_esched(F, tb, 8);
        ProbExpert<8, false> P{2048, 2048, 2048, F.G, bx, tb, (const unsigned char*)(F.ws + WS_H), (const unsigned char*)(F.ws + WS_WD), (size_t)2048 * 2048, (const void*)(F.ws + WS_ELGATE), F.in[I_BD], nullptr, F.lds + XTRA_OFF};
        if (F.tid < 128) P.table_entry(F.tid, tb + 256 + F.tid * 8);
        __syncthreads();
        EpiDown E{tb, (unsigned char*)(F.ws + WS_Y), F.lds + XTRA_OFF};
        REP(13) pg8::gemm_phase<EpiDown, ProbExpert<8, false>, true>(F.lds, P, E);
        SEAM(13);
    }
    if (IN(14)) { build_esched(F, tb, 8); p_final(F, tb); }
#undef IN
#undef SEAM
}

extern "C" void kernel_launch(void* const* d_in, const int* in_sizes, int n_in, void* d_out, int out_size, void* d_ws, size_t ws_size, hipStream_t stream) {
    static int grid = 0;
    if (grid == 0) {
        if (n_in != 27 || out_size != NTOK * DM || ws_size < WS_END) { fprintf(stderr, "kernel_launch: unexpected problem (n_in %d, out %d, ws %zu)\n", n_in, out_size, ws_size); grid = -1; return; }
        int dev = 0, cus = 0, per_cu = 0;
        if (hipGetDevice(&dev) != hipSuccess || hipDeviceGetAttribute(&cus, hipDeviceAttributeMultiprocessorCount, dev) != hipSuccess) { grid = -1; return; }
        if (hipFuncSetAttribute((const void*)mk_fwd, hipFuncAttributeMaxDynamicSharedMemorySize, LDS_BYTES) != hipSuccess) { fprintf(stderr, "kernel_launch: hipFuncSetAttribute failed\n"); grid = -1; return; }
        if (hipOccupancyMaxActiveBlocksPerMultiprocessor(&per_cu, (const void*)mk_fwd, NWAVES * 64, LDS_BYTES) != hipSuccess || per_cu < 1) { fprintf(stderr, "kernel_launch: occupancy query says %d\n", per_cu); }
        (void)hipGetLastError();
        if (cus < 128) { fprintf(stderr, "kernel_launch: %d CUs: this kernel's schedules assume the 256-CU MI355X (at least 128)\n", cus); grid = -1; return; }
        grid = cus;
    }
    if (grid < 0) return;
    (void)hipMemsetAsync((char*)d_ws + WS_CTL, 0, CTL_ZERO_BYTES, stream);
    Args a{};
    for (int i = 0; i < 27; ++i) a.in[i] = (const float*)d_in[i];
    a.out = (float*)d_out; a.ws = (unsigned char*)d_ws;
#if MK_ONE_LAUNCH
    a.ph_lo = 0; a.ph_hi = NPHASE;
    hipLaunchKernelGGL(mk_fwd, dim3(grid), dim3(NWAVES * 64), LDS_BYTES, stream, a);
#else
    for (int p = 0; p < NPHASE; ++p) { a.ph_lo = p; a.ph_hi = p + 1; hipLaunchKernelGGL(mk_fwd, dim3(grid), dim3(NWAVES * 64), LDS_BYTES, stream, a); }
#endif
}
```
